# Optimizing an MI355X kernel written in HIP

```python
import math
import jax
import jax.numpy as jnp
from jax import lax
import numpy as np

D_MODEL = 1024
BATCH = 8
SEQ = 2048
DEPTH = 4
DEC_BATCH = 128
DEC_SEQ = 4
PAST_LEN = 16384
PAGE_SIZE = 128

N_META = 16
D_MIX = D_MODEL
D_BRANCH = D_MIX // 4

SSD_HEAD_DIM = 64
SSD_HEADS = D_BRANCH // SSD_HEAD_DIM
SSD_STATE = 64
SSD_GROUPS = 2
SSD_CONV = 4
SSD_CHUNK = 128
SSD_XBC = D_BRANCH + 2 * SSD_GROUPS * SSD_STATE

S5_GROUP = 16
S5_GROUPS = D_BRANCH // S5_GROUP
S5_STATE = 64

GDN_HEAD_DIM = 64
GDN_HEADS = D_BRANCH // GDN_HEAD_DIM
GDN_CONV = 4
GDN_CHUNK = 64
GDN_QKV = 3 * D_BRANCH

HG_HEAD_DIM = 64
HG_HEADS = D_BRANCH // HG_HEAD_DIM
HG_CHUNK = 64

_IN_SIZES = (D_BRANCH, SSD_XBC, SSD_HEADS,
             D_BRANCH, D_BRANCH,
             D_BRANCH, GDN_QKV, GDN_HEADS, GDN_HEADS,
             D_BRANCH, D_BRANCH, D_BRANCH, D_BRANCH)
D_IN = 8 * D_BRANCH + SSD_XBC + GDN_QKV + SSD_HEADS + 2 * GDN_HEADS

DN_ALPHA = (2 * DEPTH) ** 0.25
DN_BETA = (8 * DEPTH) ** -0.25
LN_EPS = 1e-5
RMS_EPS = 1e-6
L2_EPS = 1e-6

kernel_name = 'hybrid_ssd_s5_gdn_hgrn2_step'


def _split_last(t, sizes):
    out = []
    start = 0
    for size in sizes:
        out.append(t[..., start:start + size])
        start += size
    return out


def _layernorm(x, g, b):
    xf = x.astype(jnp.float32)
    mu = jnp.mean(xf, -1, keepdims=True)
    var = jnp.mean(jnp.square(xf - mu), -1, keepdims=True)
    return ((xf - mu) * lax.rsqrt(var + LN_EPS) * g + b).astype(x.dtype)


def _rms_heads(y, g):
    return y * lax.rsqrt(jnp.mean(jnp.square(y), -1, keepdims=True) + RMS_EPS) * g


def _l2norm(t):
    return t * lax.rsqrt(jnp.sum(jnp.square(t), -1, keepdims=True) + L2_EPS)


def _causal_conv(x, buf, w, b):
    c = x.shape[-1]
    width = w.shape[0]
    xx = jnp.concatenate([buf.astype(x.dtype), x], axis=1)
    y = lax.conv_general_dilated(xx, w[:, None, :].astype(x.dtype), window_strides=(1,), padding='VALID',
                                 dimension_numbers=('NWC', 'WIO', 'NWC'), feature_group_count=c)
    return y + b, xx[:, xx.shape[1] - (width - 1):]


def _chunk_len(t_len, chunk):
    return chunk if t_len % chunk == 0 else t_len


def _with_prefix(fn, seqs, s0, prefix, chunk):
    if prefix > 0:
        y0, s = fn(*[a[:, :prefix] for a in seqs], s0, prefix)
        rest = [a[:, prefix:] for a in seqs]
        y1, s = fn(*rest, s, _chunk_len(rest[0].shape[1], chunk))
        return jnp.concatenate([y0, y1], axis=1), s
    return fn(*seqs, s0, _chunk_len(seqs[0].shape[1], chunk))


def _ssd_chunked(x, dt, a, bm, cm, s0, chunk):
    bsz, t_len, n_heads, _ = x.shape
    nc = t_len // chunk
    rep = n_heads // bm.shape[2]
    bh = jnp.repeat(bm, rep, axis=2)
    chh = jnp.repeat(cm, rep, axis=2)

    def ch(t):
        return t.reshape((bsz, nc, chunk) + t.shape[2:])

    xdt = ch(x * dt[..., None])
    bc, cc = ch(bh), ch(chh)
    acum = jnp.cumsum(ch(a), axis=2)
    incl = jnp.tril(jnp.ones((chunk, chunk), dtype=bool))
    seg = acum[:, :, :, None, :] - acum[:, :, None, :, :]
    lmat = jnp.exp(jnp.where(incl[:, :, None], seg, -jnp.inf))
    scores = jnp.einsum('bcihn,bcjhn->bcijh', cc, bc) * lmat
    y_diag = jnp.einsum('bcijh,bcjhp->bcihp', scores, xdt)
    to_end = jnp.exp(acum[:, :, -1:, :] - acum)
    chunk_state = jnp.einsum('bcjhn,bcjh,bcjhp->bchnp', bc, to_end, xdt)
    chunk_decay = jnp.exp(acum[:, :, -1, :])

    def step(s, inp):
        cs, cd = inp
        return s * cd[..., None, None] + cs, s

    s_fin, s_in = lax.scan(step, s0, (chunk_state.swapaxes(0, 1), chunk_decay.swapaxes(0, 1)))
    y_off = jnp.einsum('bcihn,cbhnp,bcih->bcihp', cc, s_in, jnp.exp(acum))
    return (y_diag + y_off).reshape(x.shape), s_fin


def _s5_scan(u, lam_re, lam_im, log_dt, b_re, b_im, c_re, c_im, d, s0_re, s0_im):
    dt = jnp.exp(log_dt)[:, None]
    mag = jnp.exp(lam_re * dt)
    ang = lam_im * dt
    lb_re = mag * jnp.cos(ang)
    lb_im = mag * jnp.sin(ang)
    den = jnp.square(lam_re) + jnp.square(lam_im)
    nr = lb_re - 1.0
    coef_re = (nr * lam_re + lb_im * lam_im) / den
    coef_im = (lb_im * lam_re - nr * lam_im) / den
    bb_re = coef_re[..., None] * b_re - coef_im[..., None] * b_im
    bb_im = coef_re[..., None] * b_im + coef_im[..., None] * b_re
    bu_re = jnp.einsum('btgq,gnq->btgn', u, bb_re)
    bu_im = jnp.einsum('btgq,gnq->btgn', u, bb_im)
    bu_re = bu_re.at[:, 0].add(lb_re * s0_re - lb_im * s0_im)
    bu_im = bu_im.at[:, 0].add(lb_re * s0_im + lb_im * s0_re)
    a_re = jnp.broadcast_to(lb_re, bu_re.shape)
    a_im = jnp.broadcast_to(lb_im, bu_im.shape)

    def combine(e1, e2):
        a1r, a1i, b1r, b1i = e1
        a2r, a2i, b2r, b2i = e2
        return (a2r * a1r - a2i * a1i, a2r * a1i + a2i * a1r,
                a2r * b1r - a2i * b1i + b2r, a2r * b1i + a2i * b1r + b2i)

    _, _, h_re, h_im = lax.associative_scan(combine, (a_re, a_im, bu_re, bu_im), axis=1)
    y = (jnp.einsum('gqn,btgn->btgq', c_re, h_re) - jnp.einsum('gqn,btgn->btgq', c_im, h_im)
         + d * u)
    return y, h_re[:, -1], h_im[:, -1]


def _gdn_chunked(q, k, v, beta, g, s0, chunk):
    bsz, t_len, n_heads, dk = q.shape
    dv = v.shape[-1]
    nc = t_len // chunk

    def ch(t):
        return t.reshape((bsz, nc, chunk) + t.shape[2:])

    q = ch(q * dk ** -0.5)
    k, v, beta = ch(k), ch(v), ch(beta)
    gc = jnp.cumsum(ch(g), axis=2)
    incl = jnp.tril(jnp.ones((chunk, chunk), dtype=bool))
    strict = jnp.tril(jnp.ones((chunk, chunk), dtype=bool), -1)
    diff = gc[:, :, :, None, :] - gc[:, :, None, :, :]
    dec = jnp.exp(jnp.where(incl[:, :, None], diff, -jnp.inf))
    kk = jnp.einsum('bcihd,bcjhd->bcijh', k, k)
    m = jnp.where(strict[:, :, None], kk * dec * beta[:, :, :, None, :], 0.0)
    m = m.transpose(0, 1, 4, 2, 3)
    eye = jnp.eye(chunk, dtype=m.dtype)
    tinv = lax.linalg.triangular_solve(eye + m, jnp.broadcast_to(eye, m.shape),
                                       left_side=True, lower=True, unit_diagonal=True)
    u_val = jnp.einsum('bchij,bcjhd->bcihd', tinv, v * beta[..., None])
    w_key = jnp.einsum('bchij,bcjhd->bcihd', tinv, k * (beta * jnp.exp(gc))[..., None])
    aq = jnp.einsum('bcihd,bcjhd->bcijh', q, k) * dec

    def step(s, inp):
        qi, ki, ui, wi, gi, ai = inp
        v_new = ui - jnp.einsum('blhk,bhkv->blhv', wi, s)
        o = (jnp.einsum('blhk,bhkv->blhv', qi * jnp.exp(gi)[..., None], s)
             + jnp.einsum('blsh,bshv->blhv', ai, v_new))
        gl = gi[:, -1]
        s = (s * jnp.exp(gl)[..., None, None]
             + jnp.einsum('bshk,bshv->bhkv', ki * jnp.exp(gl[:, None] - gi)[..., None], v_new))
        return s, o

    xs = tuple(t.swapaxes(0, 1) for t in (q, k, u_val, w_key, gc, aq))
    s_fin, o = lax.scan(step, s0, xs)
    return o.swapaxes(0, 1).reshape(bsz, t_len, n_heads, dv), s_fin


def _hgrn_chunked(q, k, v, logf, s0, chunk):
    bsz, t_len, n_heads, _ = q.shape
    dv = v.shape[-1]
    nc = t_len // chunk

    def ch(t):
        return t.reshape((bsz, nc, chunk) + t.shape[2:])

    gc = jnp.cumsum(ch(logf), axis=2)
    incl = jnp.tril(jnp.ones((chunk, chunk), dtype=bool))

    def step(s, inp):
        qi, ki, vi, gi = inp
        diff = gi[:, :, None] - gi[:, None]
        dec = jnp.exp(jnp.where(incl[:, :, None, None], diff, -jnp.inf))
        a = jnp.einsum('bihk,bjhk,bijhk->bijh', qi, ki, dec)
        o = (jnp.einsum('bijh,bjhv->bihv', a, vi)
             + jnp.einsum('bihk,bhkv->bihv', qi * jnp.exp(gi), s))
        gl = gi[:, -1]
        s = s * jnp.exp(gl)[..., None] + jnp.einsum('bjhk,bjhv->bhkv', ki * jnp.exp(gl[:, None] - gi), vi)
        return s, o

    xs = tuple(t.swapaxes(0, 1) for t in (ch(q), ch(k), ch(v), gc))
    s_fin, o = lax.scan(step, s0, xs)
    return o.swapaxes(0, 1).reshape(bsz, t_len, n_heads, dv), s_fin


def _hgrn_lower_bounds(lb_raw):
    p = jax.nn.softmax(lb_raw.astype(jnp.float32), axis=0)
    c = jnp.cumsum(p, axis=0)
    return c - c[0]


def _layer(x, st, lw, lb, prefix):
    lw = {k: (v if k in ('w_in', 'w_out') else v.astype(jnp.float32)) for k, v in lw.items()}
    s_ssd, c_ssd, s5r, s5i, s_gdn, c_gdn, s_hg = [s.astype(jnp.float32) for s in st]
    bsz, t_len, _ = x.shape
    u = jnp.einsum('btd,de->bte', x, lw['w_in']).astype(jnp.float32)
    (z_a, xbc, dt_raw, z_b, u_b, z_c, qkv, b_raw, a_raw,
     z_d, q_d, f_d, i_d) = _split_last(u, _IN_SIZES)

    xbc, c_ssd_new = _causal_conv(xbc, c_ssd, lw['ssd_conv_w'], lw['ssd_conv_b'])
    xbc = jax.nn.silu(xbc)
    xs, bm, cm = _split_last(xbc, (D_BRANCH, SSD_GROUPS * SSD_STATE, SSD_GROUPS * SSD_STATE))
    xs = xs.reshape(bsz, t_len, SSD_HEADS, SSD_HEAD_DIM)
    bm = bm.reshape(bsz, t_len, SSD_GROUPS, SSD_STATE)
    cm = cm.reshape(bsz, t_len, SSD_GROUPS, SSD_STATE)
    dt = jax.nn.softplus(dt_raw + lw['ssd_dt_bias'])
    a = -dt * jnp.exp(lw['ssd_a_log'])
    y, s_ssd_new = _with_prefix(_ssd_chunked, (xs, dt, a, bm, cm), s_ssd, prefix, SSD_CHUNK)
    y = y + lw['ssd_d'][:, None] * xs
    y_a = _rms_heads(y, lw['ssd_norm_g']).reshape(bsz, t_len, D_BRANCH) * jax.nn.silu(z_a)

    y5, s5r_new, s5i_new = _s5_scan(u_b.reshape(bsz, t_len, S5_GROUPS, S5_GROUP),
                                    lw['s5_lam_re'], lw['s5_lam_im'], lw['s5_log_dt'],
                                    lw['s5_b_re'], lw['s5_b_im'], lw['s5_c_re'], lw['s5_c_im'],
                                    lw['s5_d'], s5r, s5i)
    y5 = jax.nn.gelu(y5.reshape(bsz, t_len, D_BRANCH))
    y5 = y5 * jax.nn.sigmoid(jnp.einsum('btc,ce->bte', y5, lw['s5_glu_w']) + lw['s5_glu_b'])
    y_b = y5 * jax.nn.silu(z_b)

    qkv, c_gdn_new = _causal_conv(qkv, c_gdn, lw['gdn_conv_w'], lw['gdn_conv_b'])
    qkv = jax.nn.silu(qkv)
    q, k, v = [t.reshape(bsz, t_len, GDN_HEADS, GDN_HEAD_DIM)
               for t in _split_last(qkv, (D_BRANCH, D_BRANCH, D_BRANCH))]
    q, k = _l2norm(q), _l2norm(k)
    beta = jax.nn.sigmoid(b_raw)
    g = -jnp.exp(lw['gdn_a_log']) * jax.nn.softplus(a_raw + lw['gdn_dt_bias'])
    o, s_gdn_new = _with_prefix(_gdn_chunked, (q, k, v, beta, g), s_gdn, prefix, GDN_CHUNK)
    y_c = _rms_heads(o, lw['gdn_norm_g']).reshape(bsz, t_len, D_BRANCH) * jax.nn.silu(z_c)

    lb_h = lb.reshape(HG_HEADS, HG_HEAD_DIM)
    f_h = f_d.reshape(bsz, t_len, HG_HEADS, HG_HEAD_DIM)
    logf = jnp.logaddexp(jnp.log(lb_h), jnp.log1p(-lb_h) + jax.nn.log_sigmoid(f_h))
    k_h = (1.0 - lb_h) * jax.nn.sigmoid(-f_h)
    q_h = jax.nn.silu(q_d).reshape(bsz, t_len, HG_HEADS, HG_HEAD_DIM)
    v_h = i_d.reshape(bsz, t_len, HG_HEADS, HG_HEAD_DIM)
    o, s_hg_new = _with_prefix(_hgrn_chunked, (q_h, k_h, v_h, logf), s_hg, prefix, HG_CHUNK)
    y_d = _rms_heads(o, lw['hg_norm_g']).reshape(bsz, t_len, D_BRANCH) * jax.nn.silu(z_d)

    mix = jnp.concatenate([y_a, y_b, y_c, y_d], axis=-1).astype(x.dtype)
    out = jnp.einsum('btc,cd->btd', mix, lw['w_out'])
    x_new = _layernorm(DN_ALPHA * x + out, lw['ln_g'], lw['ln_b'])
    return x_new, (s_ssd_new, c_ssd_new, s5r_new, s5i_new, s_gdn_new, c_gdn_new, s_hg_new)


def setup_inputs(seed: int = 0) -> dict:
    key = jax.random.key(seed)
    keys = iter(jax.random.split(key, 64))
    f32 = jnp.float32
    L = DEPTH

    def nrm(shape, scale):
        return scale * jax.random.normal(next(keys), shape, f32)

    def unif(shape, lo, hi):
        return jax.random.uniform(next(keys), shape, f32, lo, hi)

    def dt_bias(shape):
        dt = jnp.exp(unif(shape, math.log(1e-3), math.log(1e-1)))
        return dt + jnp.log(-jnp.expm1(-dt))

    inp = {}
    inp['x_prompt'] = nrm((BATCH, SEQ, D_MODEL), 1.0)
    inp['x_sample'] = nrm((DEC_BATCH, DEC_SEQ, D_MODEL), 1.0)
    inp['state_ssd'] = nrm((L, DEC_BATCH, SSD_HEADS, SSD_STATE, SSD_HEAD_DIM), 0.1)
    inp['state_ssd_conv'] = nrm((L, DEC_BATCH, SSD_CONV - 1, SSD_XBC), 1.0)
    inp['state_s5_re'] = nrm((L, DEC_BATCH, S5_GROUPS, S5_STATE), 0.1)
    inp['state_s5_im'] = nrm((L, DEC_BATCH, S5_GROUPS, S5_STATE), 0.1)
    inp['state_gdn'] = nrm((L, DEC_BATCH, GDN_HEADS, GDN_HEAD_DIM, GDN_HEAD_DIM), 0.1)
    inp['state_gdn_conv'] = nrm((L, DEC_BATCH, GDN_CONV - 1, GDN_QKV), 1.0)
    inp['state_hgrn'] = nrm((L, DEC_BATCH, HG_HEADS, HG_HEAD_DIM, HG_HEAD_DIM), 0.1)
    inp['meta_tokens'] = nrm((N_META, D_MODEL), 1.0)
    inp['ln_in_g'] = 1.0 + nrm((D_MODEL,), 0.02)
    inp['ln_in_b'] = nrm((D_MODEL,), 0.02)
    inp['w_in'] = nrm((L, D_MODEL, D_IN), D_MODEL ** -0.5)
    inp['ssd_conv_w'] = nrm((L, SSD_CONV, SSD_XBC), SSD_CONV ** -0.5)
    inp['ssd_conv_b'] = nrm((L, SSD_XBC), 0.02)
    inp['ssd_dt_bias'] = dt_bias((L, SSD_HEADS))
    inp['ssd_a_log'] = jnp.log(unif((L, SSD_HEADS), 1.0, 16.0))
    inp['ssd_d'] = 1.0 + nrm((L, SSD_HEADS), 0.1)
    inp['ssd_norm_g'] = 1.0 + nrm((L, SSD_HEADS, SSD_HEAD_DIM), 0.02)
    inp['s5_lam_re'] = -0.5 + nrm((L, S5_GROUPS, S5_STATE), 0.01)
    inp['s5_lam_im'] = math.pi * jnp.arange(S5_STATE, dtype=f32) + nrm((L, S5_GROUPS, S5_STATE), 0.01)
    inp['s5_log_dt'] = unif((L, S5_GROUPS), math.log(1e-3), math.log(1e-1))
    inp['s5_b_re'] = nrm((L, S5_GROUPS, S5_STATE, S5_GROUP), (2 * S5_GROUP) ** -0.5)
    inp['s5_b_im'] = nrm((L, S5_GROUPS, S5_STATE, S5_GROUP), (2 * S5_GROUP) ** -0.5)
    inp['s5_c_re'] = nrm((L, S5_GROUPS, S5_GROUP, S5_STATE), S5_STATE ** -0.5)
    inp['s5_c_im'] = nrm((L, S5_GROUPS, S5_GROUP, S5_STATE), S5_STATE ** -0.5)
    inp['s5_d'] = nrm((L, S5_GROUPS, S5_GROUP), 1.0)
    inp['s5_glu_w'] = nrm((L, D_BRANCH, D_BRANCH), D_BRANCH ** -0.5)
    inp['s5_glu_b'] = nrm((L, D_BRANCH), 0.02)
    inp['gdn_conv_w'] = nrm((L, GDN_CONV, GDN_QKV), GDN_CONV ** -0.5)
    inp['gdn_conv_b'] = nrm((L, GDN_QKV), 0.02)
    inp['gdn_a_log'] = jnp.log(unif((L, GDN_HEADS), 1.0, 16.0))
    inp['gdn_dt_bias'] = dt_bias((L, GDN_HEADS))
    inp['gdn_norm_g'] = 1.0 + nrm((L, GDN_HEADS, GDN_HEAD_DIM), 0.02)
    inp['hg_lb_raw'] = nrm((L, D_BRANCH), 0.5)
    inp['hg_norm_g'] = 1.0 + nrm((L, HG_HEADS, HG_HEAD_DIM), 0.02)
    inp['w_out'] = nrm((L, D_MIX, D_MODEL), D_MIX ** -0.5 * DN_BETA)
    inp['ln_g'] = 1.0 + nrm((L, D_MODEL), 0.02)
    inp['ln_b'] = nrm((L, D_MODEL), 0.02)
    return inp


def reference(x_prompt, x_sample, state_ssd, state_ssd_conv, state_s5_re, state_s5_im, state_gdn,
              state_gdn_conv, state_hgrn, meta_tokens, ln_in_g, ln_in_b, w_in, ssd_conv_w, ssd_conv_b,
              ssd_dt_bias, ssd_a_log, ssd_d, ssd_norm_g, s5_lam_re, s5_lam_im, s5_log_dt, s5_b_re,
              s5_b_im, s5_c_re, s5_c_im, s5_d, s5_glu_w, s5_glu_b, gdn_conv_w, gdn_conv_b, gdn_a_log,
              gdn_dt_bias, gdn_norm_g, hg_lb_raw, hg_norm_g, w_out, ln_g, ln_b):
    f32 = jnp.float32
    bp = x_prompt.shape[0]
    lbs = _hgrn_lower_bounds(hg_lb_raw)
    meta = jnp.broadcast_to(meta_tokens[None].astype(x_prompt.dtype), (bp, N_META, D_MODEL))
    hp = _layernorm(jnp.concatenate([meta, x_prompt], axis=1), ln_in_g, ln_in_b)
    hs = _layernorm(x_sample, ln_in_g, ln_in_b)
    zero_st = (jnp.zeros((bp, SSD_HEADS, SSD_STATE, SSD_HEAD_DIM), f32),
               jnp.zeros((bp, SSD_CONV - 1, SSD_XBC), f32),
               jnp.zeros((bp, S5_GROUPS, S5_STATE), f32),
               jnp.zeros((bp, S5_GROUPS, S5_STATE), f32),
               jnp.zeros((bp, GDN_HEADS, GDN_HEAD_DIM, GDN_HEAD_DIM), f32),
               jnp.zeros((bp, GDN_CONV - 1, GDN_QKV), f32),
               jnp.zeros((bp, HG_HEADS, HG_HEAD_DIM, HG_HEAD_DIM), f32))
    p_states, s_states = [], []
    for l in range(DEPTH):
        lw = dict(w_in=w_in[l], ssd_conv_w=ssd_conv_w[l], ssd_conv_b=ssd_conv_b[l],
                  ssd_dt_bias=ssd_dt_bias[l], ssd_a_log=ssd_a_log[l], ssd_d=ssd_d[l],
                  ssd_norm_g=ssd_norm_g[l], s5_lam_re=s5_lam_re[l], s5_lam_im=s5_lam_im[l],
                  s5_log_dt=s5_log_dt[l], s5_b_re=s5_b_re[l], s5_b_im=s5_b_im[l], s5_c_re=s5_c_re[l],
                  s5_c_im=s5_c_im[l], s5_d=s5_d[l], s5_glu_w=s5_glu_w[l], s5_glu_b=s5_glu_b[l],
                  gdn_conv_w=gdn_conv_w[l], gdn_conv_b=gdn_conv_b[l], gdn_a_log=gdn_a_log[l],
                  gdn_dt_bias=gdn_dt_bias[l], gdn_norm_g=gdn_norm_g[l], hg_norm_g=hg_norm_g[l],
                  w_out=w_out[l], ln_g=ln_g[l], ln_b=ln_b[l])
        hp, stp = _layer(hp, zero_st, lw, lbs[l], N_META)
        st_in = (state_ssd[l], state_ssd_conv[l], state_s5_re[l], state_s5_im[l],
                 state_gdn[l], state_gdn_conv[l], state_hgrn[l])
        hs, sts = _layer(hs, st_in, lw, lbs[l], 0)
        p_states.append(stp)
        s_states.append(sts)
    p_ssd, p_ssd_conv, p_s5_re, p_s5_im, p_gdn, p_gdn_conv, p_hgrn = [
        jnp.stack([s[i] for s in p_states]) for i in range(7)]
    s_ssd, s_ssd_conv, s_s5_re, s_s5_im, s_gdn, s_gdn_conv, s_hgrn = [
        jnp.stack([s[i] for s in s_states]) for i in range(7)]
    y_prompt = hp[:, N_META:]
    y_sample = hs
    return (y_prompt, y_sample, p_ssd, p_ssd_conv, p_s5_re, p_s5_im, p_gdn, p_gdn_conv, p_hgrn,
            s_ssd, s_ssd_conv, s_s5_re, s_s5_im, s_gdn, s_gdn_conv, s_hgrn)
```

```cpp
#include <hip/hip_runtime.h>
#include <hip/hip_cooperative_groups.h>
#include <cstdio>
namespace cg = cooperative_groups;
namespace pg8 {
#define PG8_LAS __attribute__((address_space(3)))
typedef unsigned short bf16_t;
typedef short bf16x8 __attribute__((ext_vector_type(8)));
typedef float f32x4 __attribute__((ext_vector_type(4)));
typedef unsigned u32x4 __attribute__((ext_vector_type(4)));
constexpr int BM = 256, BK = 64, HALF = 128, HTB = HALF * BK * 2  , STAGE_BYTES = 8 * HTB, NXCD = 8, WGM = 8;

__host__ __device__ __forceinline__ int lds_byte(int r, int c) { const int st = (r >> 4) * 2 + (c >> 5), rr = r & 15, cc = c & 31, ob = rr * 64 + cc * 2; return st * 1024 + (ob ^ (((ob >> 9) & 1) << 5)); }
__host__ __device__ __forceinline__ void stage_rc(int b, int& R, int& C) { const int st = b / 1024, sb = b % 1024, swz = sb ^ (((sb >> 9) & 1) << 5); R = (st >> 1) * 16 + swz / 64; C = (st & 1) * 32 + (swz % 64) / 2; }
__host__ __device__ __forceinline__ int perm32(int rho) { const int n = rho >> 4, i = rho & 15; return 8 * (i >> 2) + 4 * n + (i & 3); }

struct Unit { int pm, pn; };
struct Gemm { const bf16_t* A; const bf16_t* Bt; int M, N, K; };

struct StaticOrder {
    int nM, nN, nwg, G, c;
    __host__ __device__ void init(int M, int N, int G_, int c_) { nM = M / BM; nN = N / BM; nwg = nM * nN; G = G_; c = c_; }
    __host__ __device__ bool next(int i, Unit& u) const {
        const int L = i * G + c; if (L >= nwg) return false;
        int wgid = L; { const int q = nwg / NXCD, r = nwg % NXCD, xcd = wgid % NXCD, off = wgid / NXCD; wgid = (xcd < r ? xcd * (q + 1) : r * (q + 1) + (xcd - r) * q) + off; }
        const int nig = WGM * nN, gid = wgid / nig, fm = gid * WGM, gsz = (nM - fm) < WGM ? (nM - fm) : WGM;
        u.pm = fm + ((wgid % nig) % gsz); u.pn = (wgid % nig) / gsz; return true;
    }
    __device__ __forceinline__ void a_ready(const Unit&) const {}
    __device__ __forceinline__ void done(const Unit&) const {}
};
__device__ __forceinline__ unsigned cvt_pk_bf16(float lo, float hi) { unsigned r; asm volatile("v_cvt_pk_bf16_f32 %0, %1, %2" : "=v"(r) : "v"(lo), "v"(hi)); return r; }
typedef float f32x2 __attribute__((ext_vector_type(2)));
template <class Epi, class Sched, bool STAMP = false>
__device__ __forceinline__ void gemm_phase(PG8_LAS unsigned char* lds, const Gemm g, const Sched& S, const Epi& E, unsigned long long* stamps) {
    int tid_ = threadIdx.x; asm volatile("" : "+v"(tid_)); const int tid = tid_, wid = __builtin_amdgcn_readfirstlane(tid >> 6), lane = tid & 63, wr = wid >> 2, wc = wid & 3, fr = lane & 15, fq = lane >> 4;
    const int K = g.K, nt = K / BK;
    int ts_lo = 0, ts_hi = 0, nts = 0; const unsigned long long rt_entry = STAMP ? (unsigned long long)wall_clock64() : 0ull;
#define PG8_STAMP() do { if (STAMP && wid == 0 && nts < 64) { const unsigned long long _c = (unsigned long long)clock64(); \
        ts_lo = (lane == nts) ? (int)(unsigned)_c : ts_lo; ts_hi = (lane == nts) ? (int)(unsigned)(_c >> 32) : ts_hi; ++nts; } } while (0)
    PG8_STAMP();
    unsigned voffA[2], voffB[2];
#pragma unroll
    for (int i = 0; i < 2; ++i) { int R, C; stage_rc(tid * 16 + i * 8192, R, C); const int Rb = Epi::PERM ? ((R & ~31) + perm32(R & 31)) : R;
        voffA[i] = (unsigned)(R * K + C) * 2u; voffB[i] = (unsigned)(Rb * K + C) * 2u; }
    const size_t kstep = (size_t)(BK * 2);
    const size_t hstep = (size_t)HALF * K * 2;
    const size_t tstep = 2 * hstep;
    const unsigned ldsw = (unsigned)wid * 1024u;
    const int aoff = lds_byte(wr * 64 + fr, fq * 8), boff = lds_byte(wc * 32 + fr, fq * 8);
#define PG8_SA(b, h) (((b) * 2 + (h)) * HTB)
#define PG8_SB(b, h) ((4 + (b) * 2 + (h)) * HTB)
#define PG8_STAGE(bufoff, gbase, voff) do { _Pragma("unroll") for (int _i = 0; _i < 2; ++_i) \
        __builtin_amdgcn_global_load_lds((const unsigned*)((const char*)(gbase) + (voff)[_i]), (PG8_LAS unsigned*)(lds + (bufoff) + ldsw + _i * 8192), 16, 0, 0); } while (0)
#define PG8_LDA(dst, b, h) do { _Pragma("unroll") for (int m = 0; m < 4; ++m) _Pragma("unroll") for (int k = 0; k < 2; ++k) dst[m][k] = *(const PG8_LAS bf16x8*)(lds + PG8_SA(b, h) + aoff + m * 2048 + k * 1024); } while (0)
#define PG8_LDB(dst, b, h) do { _Pragma("unroll") for (int n = 0; n < 2; ++n) _Pragma("unroll") for (int k = 0; k < 2; ++k) dst[n][k] = *(const PG8_LAS bf16x8*)(lds + PG8_SB(b, h) + boff + n * 2048 + k * 1024); } while (0)
#define PG8_MMA(ai, bj, At, Bt) do { __builtin_amdgcn_s_setprio(1); _Pragma("unroll") for (int m = 0; m < 4; ++m) _Pragma("unroll") for (int n = 0; n < 2; ++n) _Pragma("unroll") for (int k = 0; k < 2; ++k) \
        acc[ai][bj][m][n] = __builtin_amdgcn_mfma_f32_16x16x32_bf16(Bt[n][k], At[m][k], acc[ai][bj][m][n], 0, 0, 0); __builtin_amdgcn_s_setprio(0); } while (0)
#define PG8_WAIT_V(n) asm volatile("s_waitcnt vmcnt(" #n ")" ::: "memory")
#define PG8_WAIT_L(n) asm volatile("s_waitcnt lgkmcnt(" #n ")" ::: "memory")
#define PG8_BAR __builtin_amdgcn_s_barrier()
#define PG8_SCHED __builtin_amdgcn_sched_barrier(0)
    Unit cur, nxt; int ui = 0;
    if (!S.next(0, cur)) return;
    f32x4 acc[2][2][4][2];
#pragma unroll
    for (int a = 0; a < 2; ++a)
#pragma unroll
        for (int b = 0; b < 2; ++b)
#pragma unroll
            for (int m = 0; m < 4; ++m)
#pragma unroll
                for (int n = 0; n < 2; ++n) acc[a][b][m][n] = (f32x4){0.f, 0.f, 0.f, 0.f};
    bf16x8 At[4][2], B0[2][2], B1[2][2];
    const char* cA = (const char*)g.A + (size_t)cur.pm * tstep; const char* cB = (const char*)g.Bt + (size_t)cur.pn * tstep;
    S.a_ready(cur);
    PG8_STAGE(PG8_SB(0, 0), cB, voffB); PG8_STAGE(PG8_SA(0, 0), cA, voffA); PG8_STAGE(PG8_SB(0, 1), cB + hstep, voffB); PG8_STAGE(PG8_SA(0, 1), cA + hstep, voffA);
    if (wr == 1) PG8_BAR;
    PG8_WAIT_V(4); PG8_BAR;
    PG8_STAGE(PG8_SB(1, 0), cB + kstep, voffB); PG8_STAGE(PG8_SA(1, 0), cA + kstep, voffA); PG8_STAGE(PG8_SB(1, 1), cB + hstep + kstep, voffB);
    PG8_WAIT_V(6); PG8_BAR;
    PG8_STAMP();
    for (;;) {
        const bool has_next = S.next(ui + 1, nxt);
        const char* nA = has_next ? (const char*)g.A + (size_t)nxt.pm * tstep : cA; const char* nB = has_next ? (const char*)g.Bt + (size_t)nxt.pn * tstep : cB;
        for (int t = 0; t < nt; t += 2) {
            const bool last = (t == nt - 2);
            const char* a1 = cA + (size_t)(t + 1) * kstep;
            const char* a2 = last ? nA : cA + (size_t)(t + 2) * kstep; const char* b2 = last ? nB : cB + (size_t)(t + 2) * kstep;
            const char* a3 = a2 + kstep; const char* b3 = b2 + kstep;
            if (last && has_next) S.a_ready(nxt);
            PG8_LDB(B0, 0, 0); PG8_SCHED; PG8_LDA(At, 0, 0); PG8_STAGE(PG8_SA(1, 1), a1 + hstep, voffA);
            PG8_WAIT_L(8); PG8_BAR; PG8_WAIT_L(0); PG8_MMA(0, 0, At, B0); PG8_BAR; PG8_SCHED;
            PG8_LDB(B1, 0, 1); PG8_STAGE(PG8_SB(0, 0), b2, voffB);
            PG8_BAR; PG8_WAIT_L(0); PG8_MMA(0, 1, At, B1); PG8_BAR;
            PG8_LDA(At, 0, 1); PG8_STAGE(PG8_SA(0, 0), a2, voffA);
            PG8_BAR; PG8_WAIT_L(0); PG8_MMA(1, 0, At, B0); PG8_BAR; PG8_SCHED;
            PG8_STAGE(PG8_SB(0, 1), b2 + hstep, voffB);
            PG8_WAIT_V(6); PG8_BAR; PG8_MMA(1, 1, At, B1); PG8_BAR;
            PG8_LDB(B0, 1, 0); PG8_SCHED; PG8_LDA(At, 1, 0); PG8_STAGE(PG8_SA(0, 1), a2 + hstep, voffA);
            PG8_WAIT_L(8); PG8_BAR; PG8_WAIT_L(0); PG8_MMA(0, 0, At, B0); PG8_BAR; PG8_SCHED;
            PG8_LDB(B1, 1, 1); PG8_STAGE(PG8_SB(1, 0), b3, voffB);
            PG8_BAR; PG8_WAIT_L(0); PG8_MMA(0, 1, At, B1); PG8_BAR;
            PG8_LDA(At, 1, 1); PG8_STAGE(PG8_SA(1, 0), a3, voffA);
            PG8_BAR; PG8_WAIT_L(0); PG8_MMA(1, 0, At, B0); PG8_BAR; PG8_SCHED;
            PG8_STAGE(PG8_SB(1, 1), b3 + hstep, voffB);
            PG8_WAIT_V(6); PG8_BAR; PG8_MMA(1, 1, At, B1); PG8_BAR;
        }
        PG8_STAMP();
        if constexpr (!Epi::AFTER_DRAIN) { E(acc, cur, wr, wc, fr, fq); S.done(cur); }
        PG8_STAMP();
        if (!has_next) break;
#pragma unroll
        for (int a = 0; a < 2; ++a)
#pragma unroll
            for (int b = 0; b < 2; ++b)
#pragma unroll
                for (int m = 0; m < 4; ++m)
#pragma unroll
                    for (int n = 0; n < 2; ++n) acc[a][b][m][n] = (f32x4){0.f, 0.f, 0.f, 0.f};
        cur = nxt; cA = nA; cB = nB; ++ui;
    }
    PG8_WAIT_V(0);
    if (wr == 0) PG8_BAR;
    PG8_BAR;
    if constexpr (Epi::AFTER_DRAIN) { E.fused(acc, cur, wr, wc, fr, fq, lds, wid, lane); S.done(cur); }
    PG8_STAMP();
    if (STAMP && wid == 0) { stamps[lane] = lane < nts ? (((unsigned long long)(unsigned)ts_hi << 32) | (unsigned)ts_lo) : 0ull;
        if (lane == 62) stamps[62] = rt_entry; if (lane == 63) stamps[63] = (unsigned long long)wall_clock64(); }
#undef PG8_STAMP
#undef PG8_SA
#undef PG8_SB
#undef PG8_STAGE
#undef PG8_LDA
#undef PG8_LDB
#undef PG8_MMA
#undef PG8_WAIT_V
#undef PG8_WAIT_L
#undef PG8_BAR
#undef PG8_SCHED
}
}

namespace mk {
using pg8::bf16_t; using pg8::f32x4; using pg8::u32x4; using pg8::Unit; using pg8::cvt_pk_bf16;
typedef unsigned u32x2 __attribute__((ext_vector_type(2)));
#define MK_LAS __attribute__((address_space(3)))
typedef MK_LAS float lfloat;
typedef MK_LAS f32x4 lf32x4;

constexpr int D = 1024, DEPTH = 4, TP = 2064, BP = 8, BS = 128, TS = 4;
constexpr int M_REAL = 17024, MP = 17152, ROW_SAMPLE = 16384, ROW_META = 16896;
constexpr int D_IN = 3340, NU = 3328, NU_PAD = 3584;
constexpr int CL = 129, NCH = 16, ST = 43;
constexpr int UC_ZA = 0, UC_XBC = 256, UC_ZB = 768, UC_UB = 1024, UC_ZC = 1280, UC_QKV = 1536, UC_ZD = 2304, UC_QD = 2560, UC_FD = 2816, UC_ID = 3072;
constexpr float DN_ALPHA = 1.6817928305074290f;
constexpr float LN_EPS = 1e-5f, RMS_EPS = 1e-6f, L2_EPS = 1e-6f;

enum { I_XP = 0, I_XS, I_SSSD, I_SSSDC, I_SS5R, I_SS5I, I_SGDN, I_SGDNC, I_SHG, I_META, I_LNIG, I_LNIB, I_WIN, I_SCW, I_SCB, I_SDTB, I_SALOG, I_SD, I_SNG,
       I_LAMR, I_LAMI, I_LOGDT, I_BR, I_BI, I_CR, I_CI, I_S5D, I_GLUW, I_GLUB, I_GCW, I_GCB, I_GALOG, I_GDTB, I_GNG, I_HLB, I_HNG, I_WOUT, I_LNG, I_LNB, N_IN };

constexpr size_t O_YP = 0, O_YS = O_YP + (size_t)8 * 2048 * 1024, O_PSSD = O_YS + (size_t)128 * 4 * 1024;
constexpr size_t SZ_ST = 4 * 64 * 64, SZ_SC = 3 * 512, SZ_S5 = 16 * 64, SZ_GC = 3 * 768;
constexpr size_t O_PSSDC = O_PSSD + 4 * 8 * SZ_ST, O_PS5R = O_PSSDC + 4 * 8 * SZ_SC, O_PS5I = O_PS5R + 4 * 8 * SZ_S5, O_PGDN = O_PS5I + 4 * 8 * SZ_S5,
                 O_PGDNC = O_PGDN + 4 * 8 * SZ_ST, O_PHG = O_PGDNC + 4 * 8 * SZ_GC, O_SSSD = O_PHG + 4 * 8 * SZ_ST, O_SSSDC = O_SSSD + 4 * 128 * SZ_ST,
                 O_SS5R = O_SSSDC + 4 * 128 * SZ_SC, O_SS5I = O_SS5R + 4 * 128 * SZ_S5, O_SGDN = O_SS5I + 4 * 128 * SZ_S5, O_SGDNC = O_SGDN + 4 * 128 * SZ_ST,
                 O_SHG = O_SGDNC + 4 * 128 * SZ_GC, O_END = O_SHG + 4 * 128 * SZ_ST;
static_assert(O_END == 47243264, "d_out size");

constexpr size_t WS_WTIN = 0;
constexpr size_t WS_WTOUT = WS_WTIN + (size_t)4 * NU_PAD * 1024 * 2;
constexpr size_t WS_WTGLU = WS_WTOUT + (size_t)4 * 1024 * 1024 * 2;
constexpr size_t WS_XB = WS_WTGLU + (size_t)4 * 256 * 256 * 2;
constexpr size_t WS_XMETA = WS_XB + (size_t)MP * 1024 * 2;
constexpr size_t WS_U = WS_XMETA + (size_t)128 * 1024 * 4;
constexpr size_t WS_USM = WS_U + (size_t)MP * NU * 2;
constexpr size_t WS_Y5 = WS_USM + (size_t)MP * 16 * 4;
constexpr size_t WS_SG = WS_Y5 + (size_t)MP * 256 * 2;
constexpr size_t WS_PG = WS_SG + (size_t)32 * 16 * 4096 * 4;
constexpr size_t WS_SS = WS_PG + (size_t)32 * 16 * 4096 * 4;
constexpr size_t WS_SH = WS_SS + (size_t)32 * 16 * 4096 * 4;
constexpr size_t WS_DS = WS_SH + (size_t)32 * 16 * 4096 * 4;
constexpr size_t WS_DH = WS_DS + 4096;
constexpr size_t WS_H5 = WS_DH + (size_t)32 * 16 * 64 * 4;
constexpr size_t WS_END = WS_H5 + (size_t)8 * 16 * 16 * 128 * 4;
static_assert(WS_END <= 268435456, "ws");

constexpr int LDS_BYTES = 147456;
constexpr int L_RAW = 0, L_ACT = 35328, L_OBUF = 79360, L_SCAL = 90368, L_MISC = 90880, L_CWL = 91136, L_SBUF = 94976, L_SBUF2 = 111616;
static_assert(L_SBUF2 + 16640 <= 131072, "lds");

struct Args { const float* in[N_IN]; float* out; unsigned char* ws; int ph_lo, ph_hi; };
typedef __attribute__((address_space(4))) const Args CArgs;

__device__ __forceinline__ int otid() { int t = threadIdx.x; asm volatile("" : "+v"(t)); return t; }
#define MK_OPQ(p) asm volatile("" : "+s"(p))
__device__ __forceinline__ int obid() { int t = blockIdx.x; asm volatile("" : "+s"(t)); return t; }
__device__ __forceinline__ float bf2f(bf16_t v) { return __uint_as_float(((unsigned)v) << 16); }
__device__ __forceinline__ bf16_t f2bf(float f) { unsigned u = __float_as_uint(f); return (bf16_t)((u + 0x7fffu + ((u >> 16) & 1u)) >> 16); }
__device__ __forceinline__ unsigned pk2(float lo, float hi) { return (unsigned)f2bf(lo) | ((unsigned)f2bf(hi) << 16); }
__device__ __forceinline__ float sigm(float x) { return __builtin_amdgcn_rcpf(1.f + __expf(-x)); }
__device__ __forceinline__ float silu(float x) { return x * __builtin_amdgcn_rcpf(1.f + __expf(-x)); }
__device__ __forceinline__ float softplus(float x) { const float e = __expf(x); return x > 15.f ? x : (e < 0.01f ? e * (1.f - e * (0.5f - e * 0.33333333f)) : __logf(1.f + e)); }
__device__ __forceinline__ float gelu_tanh(float x) { const float u = 0.7978845608028654f * (x + 0.044715f * x * x * x); const float t = __expf(2.f * u); return 0.5f * x * (2.f - 2.f * __builtin_amdgcn_rcpf(1.f + t)); }
__device__ __forceinline__ float wave_sum(float v, int lane) {
#pragma unroll
    for (int o = 1; o < 64; o <<= 1) v += __builtin_bit_cast(float, __builtin_amdgcn_ds_bpermute((lane ^ o) << 2, __builtin_bit_cast(int, v)));
    return v;
}
__device__ __forceinline__ float red8(float x) {
    x += __builtin_bit_cast(float, __builtin_amdgcn_update_dpp(0, __builtin_bit_cast(int, x), 0xB1, 0xF, 0xF, true));
    x += __builtin_bit_cast(float, __builtin_amdgcn_update_dpp(0, __builtin_bit_cast(int, x), 0x4E, 0xF, 0xF, true));
    x += __builtin_bit_cast(float, __builtin_amdgcn_update_dpp(0, __builtin_bit_cast(int, x), 0x141, 0xF, 0xF, true));
    return x;
}
__device__ __forceinline__ int prow(int b, int t) { return t < 16 ? ROW_META + b * 16 + t : b * 2048 + t - 16; }
__device__ __forceinline__ float* xrow_ptr(CArgs& a, int row) { return row < ROW_META ? a.out + (size_t)row * D : (float*)(a.ws + WS_XMETA) + (size_t)(row - ROW_META) * D; }

__device__ __forceinline__ void transpose_item(const float* W, int ldw, int K, int k0, int ns0, bf16_t* WT, int nd0, lfloat* scr, int lane) {
#pragma unroll 8
    for (int i = 0; i < 32; ++i) { const int kk = 2 * i + (lane >> 5); scr[kk * 33 + (lane & 31)] = W[(size_t)(k0 + kk) * ldw + ns0 + (lane & 31)]; }
    __builtin_amdgcn_wave_barrier(); asm volatile("s_waitcnt lgkmcnt(0)" ::: "memory");
    const int c = lane & 7;
#pragma unroll
    for (int j = 0; j < 4; ++j) { const int n = (lane >> 3) + 8 * j; const lfloat* s = scr + (8 * c) * 33 + n;
        u32x4 o; o.x = pk2(s[0 * 33], s[1 * 33]); o.y = pk2(s[2 * 33], s[3 * 33]); o.z = pk2(s[4 * 33], s[5 * 33]); o.w = pk2(s[6 * 33], s[7 * 33]);
        *(u32x4*)(WT + (size_t)(nd0 + n) * K + k0 + 8 * c) = o; }
    __builtin_amdgcn_wave_barrier(); asm volatile("s_waitcnt lgkmcnt(0)" ::: "memory");
}
__device__ __forceinline__ void ln_row(const float* src, const float* g, const float* bb, float* dstf, bf16_t* dstb, int lane) {
    const f32x4* xr = (const f32x4*)src + lane;
    f32x4 v[4]; float s = 0.f;
#pragma unroll
    for (int j = 0; j < 4; ++j) { v[j] = xr[64 * j]; s += (v[j].x + v[j].y) + (v[j].z + v[j].w); }
    const float mean = wave_sum(s, lane) * (1.f / D); float s2 = 0.f;
#pragma unroll
    for (int j = 0; j < 4; ++j) { v[j] = v[j] - mean; s2 += (v[j].x * v[j].x + v[j].y * v[j].y) + (v[j].z * v[j].z + v[j].w * v[j].w); }
    const float rstd = __builtin_amdgcn_rsqf(wave_sum(s2, lane) * (1.f / D) + LN_EPS);
#pragma unroll
    for (int j = 0; j < 4; ++j) {
        const f32x4 gv = ((const f32x4*)g)[lane + 64 * j], bv = ((const f32x4*)bb)[lane + 64 * j];
        const f32x4 o = v[j] * rstd * gv + bv;
        ((f32x4*)dstf)[lane + 64 * j] = o;
        u32x2 w; w.x = pk2(o.x, o.y); w.y = pk2(o.z, o.w);
        ((u32x2*)dstb)[lane + 64 * j] = w;
    }
}

__device__ __forceinline__ void phase_prologue(CArgs& a, unsigned char* ldsg) {
    const int tid = otid(), lane = tid & 63, wave = tid >> 6;
    lfloat* scr = (lfloat*)(MK_LAS unsigned char*)ldsg + wave * 4096;
    const int gw = obid() * 8 + wave, NGW = gridDim.x * 8;
    constexpr int I_IN = 16 * (NU / 32), I_OUT = 16 * 32, I_GLU = 4 * 8;
    constexpr int NITEMS = 4 * (I_IN + I_OUT + I_GLU);
    bf16_t* wtin = (bf16_t*)(a.ws + WS_WTIN); bf16_t* wtout = (bf16_t*)(a.ws + WS_WTOUT); bf16_t* wtglu = (bf16_t*)(a.ws + WS_WTGLU);
    for (int it = gw; it < NITEMS; it += NGW) {
        int r = it;
        if (r < 4 * I_IN) { const int l = r / I_IN; r -= l * I_IN; const int kb = r / (NU / 32), nb = r % (NU / 32); const int nd0 = nb * 32; const int ns0 = nd0 + (nd0 >= 768 ? 4 : 0) + (nd0 >= 2304 ? 8 : 0);
            transpose_item(a.in[I_WIN] + (size_t)l * 1024 * D_IN, D_IN, 1024, kb * 64, ns0, wtin + (size_t)l * NU_PAD * 1024, nd0, scr, lane); continue; }
        r -= 4 * I_IN;
        if (r < 4 * I_OUT) { const int l = r / I_OUT; r -= l * I_OUT; const int kb = r / 32, nb = r % 32;
            transpose_item(a.in[I_WOUT] + (size_t)l * 1024 * 1024, 1024, 1024, kb * 64, nb * 32, wtout + (size_t)l * 1024 * 1024, nb * 32, scr, lane); continue; }
        r -= 4 * I_OUT;
        { const int l = r / I_GLU; r -= l * I_GLU; const int kb = r / 8, nb = r % 8;
            transpose_item(a.in[I_GLUW] + (size_t)l * 256 * 256, 256, 256, kb * 64, nb * 32, wtglu + (size_t)l * 256 * 256, nb * 32, scr, lane); }
    }
    for (int idx = obid() * 512 + tid; idx < 4 * 12 * 1024; idx += gridDim.x * 512) {
        const int l = idx / (12 * 1024), r = idx % (12 * 1024), j = r >> 10, k = r & 1023; const int sc = j < 4 ? 768 + j : 2308 + (j - 4);
        wtin[((size_t)l * NU_PAD + NU + j) * 1024 + k] = f2bf(a.in[I_WIN][((size_t)l * 1024 + k) * D_IN + sc]);
    }
    bf16_t* xb = (bf16_t*)(a.ws + WS_XB);
    for (int row = gw; row < M_REAL; row += NGW) {
        const float* src = row < ROW_SAMPLE ? a.in[I_XP] + (size_t)row * D : (row < ROW_META ? a.in[I_XS] + (size_t)(row - ROW_SAMPLE) * D : a.in[I_META] + (size_t)((row - ROW_META) & 15) * D);
        ln_row(src, a.in[I_LNIG], a.in[I_LNIB], xrow_ptr(a, row), xb + (size_t)row * D, lane);
    }
}
__device__ __forceinline__ void phase_ln(CArgs& a, int l) {
    const int lane = otid() & 63, wave = otid() >> 6;
    const int gw = obid() * 8 + wave, NGW = gridDim.x * 8;
    bf16_t* xb = (bf16_t*)(a.ws + WS_XB);
    for (int row = gw; row < M_REAL; row += NGW) { float* xr = xrow_ptr(a, row); ln_row(xr, a.in[I_LNG] + l * D, a.in[I_LNB] + l * D, xr, xb + (size_t)row * D, lane); }
}

struct EpiU {
    static constexpr bool PERM = true, AFTER_DRAIN = false;
    bf16_t* U; float* USM;
    __device__ __forceinline__ void operator()(const f32x4 (&acc)[2][2][4][2], const Unit& u, int wr_, int wc_, int fr_, int fq_) const {
        const int tid = otid(), lane = tid & 63, wid = __builtin_amdgcn_readfirstlane(tid >> 6), wr = wid >> 2, wc = wid & 3, fr = lane & 15, fq = lane >> 4;
        const int row0 = u.pm * 256 + wr * 64 + fr;
        if (u.pn < 13) {
            const int col0 = u.pn * 256 + wc * 32 + 8 * fq;
#pragma unroll
            for (int ai = 0; ai < 2; ++ai)
#pragma unroll
                for (int m = 0; m < 4; ++m) { bf16_t* rowp = U + (size_t)(row0 + ai * 128 + m * 16) * NU + col0;
#pragma unroll
                    for (int bj = 0; bj < 2; ++bj) { const f32x4 v0 = acc[ai][bj][m][0], v1 = acc[ai][bj][m][1];
                        u32x4 w; w.x = cvt_pk_bf16(v0[0], v0[1]); w.y = cvt_pk_bf16(v0[2], v0[3]); w.z = cvt_pk_bf16(v1[0], v1[1]); w.w = cvt_pk_bf16(v1[2], v1[3]);
                        *(u32x4*)(rowp + bj * 128) = w; }
                    asm volatile("" ::: "memory"); }
        } else if (wc == 0 && fq < 2) {
#pragma unroll
            for (int ai = 0; ai < 2; ++ai)
#pragma unroll
                for (int m = 0; m < 4; ++m) { float* rowp = USM + (size_t)(row0 + ai * 128 + m * 16) * 16 + 8 * fq;
                    *(f32x4*)(rowp) = acc[ai][0][m][0]; *(f32x4*)(rowp + 4) = acc[ai][0][m][1]; }
        }
    }
};
struct EpiGlu {
    static constexpr bool PERM = true, AFTER_DRAIN = false;
    const bf16_t* Y5; const bf16_t* U; const float* bias; bf16_t* MIX;
    __device__ __forceinline__ void operator()(const f32x4 (&acc)[2][2][4][2], const Unit& u, int wr_, int wc_, int fr_, int fq_) const {
        const int tid = otid(), lane = tid & 63, wid = __builtin_amdgcn_readfirstlane(tid >> 6), wr = wid >> 2, wc = wid & 3, fr = lane & 15, fq = lane >> 4;
        const int row0 = u.pm * 256 + wr * 64 + fr, col0 = wc * 32 + 8 * fq;
#pragma unroll
        for (int ai = 0; ai < 2; ++ai)
#pragma unroll
            for (int m = 0; m < 4; ++m) { const size_t row = (size_t)(row0 + ai * 128 + m * 16);
#pragma unroll
                for (int bj = 0; bj < 2; ++bj) { const int col = col0 + bj * 128;
                    const u32x4 yv = *(const u32x4*)(Y5 + row * 256 + col), zv = *(const u32x4*)(U + row * NU + UC_ZB + col);
                    const f32x4 b0 = *(const f32x4*)(bias + col), b1 = *(const f32x4*)(bias + col + 4);
                    float o[8];
#pragma unroll
                    for (int j = 0; j < 8; ++j) { const float g = (j < 4 ? acc[ai][bj][m][0][j & 3] : acc[ai][bj][m][1][j & 3]) + (j < 4 ? b0[j & 3] : b1[j & 3]);
                        const unsigned yw = yv[j >> 1], zw = zv[j >> 1];
                        const float y = __uint_as_float((j & 1) ? (yw & 0xffff0000u) : (yw << 16)), z = __uint_as_float((j & 1) ? (zw & 0xffff0000u) : (zw << 16));
                        o[j] = y * sigm(g) * silu(z); }
                    u32x4 w; w.x = pk2(o[0], o[1]); w.y = pk2(o[2], o[3]); w.z = pk2(o[4], o[5]); w.w = pk2(o[6], o[7]);
                    *(u32x4*)(MIX + row * 1024 + 256 + col) = w; asm volatile("" ::: "memory"); } }
    }
};
struct EpiOut {
    static constexpr bool PERM = false, AFTER_DRAIN = false;
    float* out; float* xmeta;
    __device__ __forceinline__ void operator()(const f32x4 (&acc)[2][2][4][2], const Unit& u, int wr_, int wc_, int fr_, int fq_) const {
        const int tid = otid(), lane = tid & 63, wid = __builtin_amdgcn_readfirstlane(tid >> 6), wr = wid >> 2, wc = wid & 3, fr = lane & 15, fq = lane >> 4;
        const int row0 = u.pm * 256 + wr * 64 + fr, col0 = u.pn * 256 + wc * 32 + 4 * fq;
#pragma unroll
        for (int ai = 0; ai < 2; ++ai)
#pragma unroll
            for (int m = 0; m < 4; ++m) { const int row = row0 + ai * 128 + m * 16;
                if (row < M_REAL) { float* rowp = (row < ROW_META ? out + (size_t)row * D : xmeta + (size_t)(row - ROW_META) * D) + col0;
#pragma unroll
                    for (int bj = 0; bj < 2; ++bj)
#pragma unroll
                        for (int n = 0; n < 2; ++n) { f32x4* p = (f32x4*)(rowp + bj * 128 + n * 16); *p = (*p) * DN_ALPHA + acc[ai][bj][m][n]; } }
                asm volatile("" ::: "memory"); }
    }
};

template <int BR, int MODE>
__device__ __forceinline__ void rec_task(CArgs& a, unsigned char* ldsg, const int l, const bool sample, const int b, const int h, const int c) {
    MK_LAS unsigned char* lds = (MK_LAS unsigned char*)ldsg;
    lfloat* RAW = (lfloat*)(lds + L_RAW); lfloat* ACT = (lfloat*)(lds + L_ACT); lfloat* OBUF = (lfloat*)(lds + L_OBUF); lfloat* SCAL = (lfloat*)(lds + L_SCAL);
    lfloat* MISC = (lfloat*)(lds + L_MISC); lfloat* CWL = (lfloat*)(lds + L_CWL); lfloat* SBUF = (lfloat*)(lds + L_SBUF); lfloat* SBUF2 = (lfloat*)(lds + L_SBUF2);
    const int tid = otid(), lane = tid & 63, wave = tid >> 6, v = tid >> 3, kq = tid & 7;
    const bf16_t* U = (const bf16_t*)(a.ws + WS_U); const float* USM = (const float*)(a.ws + WS_USM); bf16_t* MIX = (bf16_t*)(a.ws + WS_XB);
    MK_OPQ(U); MK_OPQ(USM); MK_OPQ(MIX);
    const int nsteps = sample ? TS : CL, t0 = sample ? 0 : c * CL, bh = b * 4 + h, grp = h >> 1;
    const int NC = BR == 0 ? 512 : 768;
    const float* cw = BR == 0 ? a.in[I_SCW] + l * 4 * 512 : a.in[I_GCW] + l * 4 * 768;
    const float* cbias = BR == 0 ? a.in[I_SCB] + l * 512 : a.in[I_GCB] + l * 768;
    const float* cstate = BR == 0 ? a.in[I_SSSDC] + (size_t)(l * 128 + b) * 3 * 512 : a.in[I_SGDNC] + (size_t)(l * 128 + b) * 3 * 768;
    const int uc0 = BR == 0 ? UC_XBC + h * 64 : UC_QKV + h * 64, uc1 = BR == 0 ? UC_XBC + 256 + grp * 64 : UC_QKV + 256 + h * 64, uc2 = BR == 0 ? UC_XBC + 384 + grp * 64 : UC_QKV + 512 + h * 64;
    const int zcol = (BR == 0 ? UC_ZA : (BR == 1 ? UC_ZC : UC_ZD)) + h * 64, mixcol = (BR == 0 ? 0 : (BR == 1 ? 512 : 768)) + h * 64;
    const float* gnp = (BR == 0 ? a.in[I_SNG] : (BR == 1 ? a.in[I_GNG] : a.in[I_HNG])) + (l * 4 + h) * 64;
    const float gn = gnp[lane];
    const float Dh = BR == 0 ? a.in[I_SD][l * 4 + h] : 0.f;
    float* sloc = (float*)(a.ws + (BR == 0 ? WS_SS : (BR == 1 ? WS_SG : WS_SH))) + (size_t)(bh * NCH + c) * 4096;
    MK_OPQ(sloc);

    __syncthreads();
    if (BR == 2) { if (tid < 64) { const int ch = h * 64 + tid; float p[4], mx = -1e30f, sum = 0.f;
#pragma unroll
            for (int i = 0; i < 4; ++i) { p[i] = a.in[I_HLB][i * 256 + ch]; mx = fmaxf(mx, p[i]); }
#pragma unroll
            for (int i = 0; i < 4; ++i) { p[i] = __expf(p[i] - mx); sum += p[i]; }
            float lb = 0.f;
#pragma unroll
            for (int i = 1; i < 4; ++i) if (i <= l) lb += p[i];
            MISC[tid] = lb * __builtin_amdgcn_rcpf(sum); } }
    else { for (int idx = tid; idx < 5 * 192; idx += 512) { const int w = idx / 192, ch = idx - w * 192, part = ch >> 6, d = ch & 63; const int ci = (part == 0 ? uc0 : (part == 1 ? uc1 : uc2)) - (BR == 0 ? UC_XBC : UC_QKV) + d;
            CWL[idx] = w < 4 ? cw[w * NC + ci] : cbias[ci]; } }
    float S[8], S2[8];
    if (MODE == 1) {
        const float* s_in = sample ? (BR == 0 ? a.in[I_SSSD] : (BR == 1 ? a.in[I_SGDN] : a.in[I_SHG])) + (size_t)((l * 128 + b) * 4 + h) * 4096 : sloc;
        for (int idx = tid; idx < 4096; idx += 512) SBUF[(idx >> 6) * 65 + (idx & 63)] = s_in[idx];
        __syncthreads();
#pragma unroll
        for (int i = 0; i < 8; ++i) S[i] = SBUF[(kq * 8 + i) * 65 + v];
    } else {
#pragma unroll
        for (int i = 0; i < 8; ++i) { S[i] = 0.f; S2[i] = (BR == 1) ? ((kq * 8 + i == v) ? 1.f : 0.f) : 1.f; }
    }
    float decprod = 1.f;

    for (int ts = 0; ts < nsteps; ts += ST) {
        const int n = (nsteps - ts) < ST ? (nsteps - ts) : ST;
        __syncthreads();
        if (BR == 2) {
            for (int idx = tid; idx < n * 64; idx += 512) { const int s = idx >> 6, d = idx & 63, t = t0 + ts + s; const int row = sample ? ROW_SAMPLE + b * 4 + t : prow(b, t);
                const bf16_t* ur = U + (size_t)row * NU + h * 64 + d; const float lb = MISC[d];
                const float f = lb + (1.f - lb) * sigm(bf2f(ur[UC_FD]));
                ACT[s * 256 + d] = f; ACT[s * 256 + 64 + d] = silu(bf2f(ur[UC_QD])); ACT[s * 256 + 128 + d] = bf2f(ur[UC_ID]); }
            __syncthreads();
        } else {
            for (int idx = tid; idx < (n + 3) * 192; idx += 512) { const int j = idx / 192, ch = idx - j * 192, part = ch >> 6, d = ch & 63, t = t0 + ts - 3 + j; const int ucb = part == 0 ? uc0 : (part == 1 ? uc1 : uc2);
                float val = 0.f;
                if (t >= 0) { const int row = sample ? ROW_SAMPLE + b * 4 + t : prow(b, t); val = bf2f(U[(size_t)row * NU + ucb + d]); }
                else if (sample) val = cstate[(3 + t) * NC + ucb - (BR == 0 ? UC_XBC : UC_QKV) + d];
                RAW[idx] = val; }
            if (tid < n) { const int t = t0 + ts + tid; const int row = sample ? ROW_SAMPLE + b * 4 + t : prow(b, t);
                if (BR == 0) { const float dtv = softplus(USM[(size_t)row * 16 + h] + a.in[I_SDTB][l * 4 + h]); const float aa = -dtv * __expf(a.in[I_SALOG][l * 4 + h]); SCAL[tid * 2] = __expf(aa); SCAL[tid * 2 + 1] = dtv; }
                else { const float beta = sigm(USM[(size_t)row * 16 + 4 + h]); const float g = -__expf(a.in[I_GALOG][l * 4 + h]) * softplus(USM[(size_t)row * 16 + 8 + h] + a.in[I_GDTB][l * 4 + h]); SCAL[tid * 2] = __expf(g); SCAL[tid * 2 + 1] = beta; } }
            __syncthreads();
            for (int idx = tid; idx < n * 192; idx += 512) { const int s = idx / 192, ch = idx - s * 192, part = ch >> 6, d = ch & 63;
                float acc = CWL[4 * 192 + ch];
#pragma unroll
                for (int w = 0; w < 4; ++w) acc += CWL[w * 192 + ch] * RAW[(s + w) * 192 + ch];
                acc = silu(acc);
                if (BR == 0) { if (part == 0) { ACT[s * 256 + 192 + d] = acc; ACT[s * 256 + 128 + d] = acc * SCAL[s * 2 + 1]; } else if (part == 1) ACT[s * 256 + d] = acc; else ACT[s * 256 + 64 + d] = acc; }
                else { if (part == 0) ACT[s * 256 + 64 + d] = acc; else if (part == 1) ACT[s * 256 + d] = acc; else ACT[s * 256 + 128 + d] = acc; } }
            __syncthreads();
            if (BR == 1) { for (int r = wave; r < 2 * n; r += 8) { const int s = r >> 1, isq = r & 1, off = s * 256 + (isq ? 64 : 0) + lane; const float x = ACT[off]; const float ss = wave_sum(x * x, lane);
                    ACT[off] = x * __builtin_amdgcn_rsqf(ss + L2_EPS) * (isq ? 0.125f : 1.f); }
                __syncthreads(); }
        }
        for (int s = 0; s < n; ++s) {
            const lfloat* ar = ACT + s * 256;
            const f32x4 a0 = *(const lf32x4*)(ar + kq * 8), a1 = *(const lf32x4*)(ar + kq * 8 + 4);
            const float A[8] = {a0[0], a0[1], a0[2], a0[3], a1[0], a1[1], a1[2], a1[3]};
            const float vv = ar[128 + v];
            if (BR == 0) {
                const float dec = SCAL[s * 2];
                if (MODE == 0) { decprod *= dec;
#pragma unroll
                    for (int i = 0; i < 8; ++i) S[i] = S[i] * dec + A[i] * vv;
                } else {
                    const f32x4 b0 = *(const lf32x4*)(ar + 64 + kq * 8), b1 = *(const lf32x4*)(ar + 64 + kq * 8 + 4);
                    const float Bq[8] = {b0[0], b0[1], b0[2], b0[3], b1[0], b1[1], b1[2], b1[3]};
                    float y = 0.f;
#pragma unroll
                    for (int i = 0; i < 8; ++i) { S[i] = S[i] * dec + A[i] * vv; y += Bq[i] * S[i]; }
                    y = red8(y); if (kq == 0) OBUF[s * 64 + v] = y;
                }
            } else if (BR == 1) {
                const float al = SCAL[s * 2], be = SCAL[s * 2 + 1];
                if (MODE == 0) {
                    float r = 0.f, rp = 0.f;
#pragma unroll
                    for (int i = 0; i < 8; ++i) { S[i] *= al; S2[i] *= al; r += A[i] * S[i]; rp += A[i] * S2[i]; }
                    r = red8(r); rp = red8(rp);
                    const float vn = be * (vv - r), vnp = -be * rp;
#pragma unroll
                    for (int i = 0; i < 8; ++i) { S[i] += A[i] * vn; S2[i] += A[i] * vnp; }
                } else {
                    const f32x4 b0 = *(const lf32x4*)(ar + 64 + kq * 8), b1 = *(const lf32x4*)(ar + 64 + kq * 8 + 4);
                    const float Bq[8] = {b0[0], b0[1], b0[2], b0[3], b1[0], b1[1], b1[2], b1[3]};
                    float r = 0.f;
#pragma unroll
                    for (int i = 0; i < 8; ++i) { S[i] *= al; r += A[i] * S[i]; }
                    r = red8(r);
                    const float vn = be * (vv - r); float o = 0.f;
#pragma unroll
                    for (int i = 0; i < 8; ++i) { S[i] += A[i] * vn; o += Bq[i] * S[i]; }
                    o = red8(o); if (kq == 0) OBUF[s * 64 + v] = o;
                }
            } else {
                if (MODE == 0) {
#pragma unroll
                    for (int i = 0; i < 8; ++i) { S[i] = A[i] * S[i] + (1.f - A[i]) * vv; S2[i] *= A[i]; }
                } else {
                    const f32x4 b0 = *(const lf32x4*)(ar + 64 + kq * 8), b1 = *(const lf32x4*)(ar + 64 + kq * 8 + 4);
                    const float Bq[8] = {b0[0], b0[1], b0[2], b0[3], b1[0], b1[1], b1[2], b1[3]};
                    float o = 0.f;
#pragma unroll
                    for (int i = 0; i < 8; ++i) { S[i] = A[i] * S[i] + (1.f - A[i]) * vv; o += Bq[i] * S[i]; }
                    o = red8(o); if (kq == 0) OBUF[s * 64 + v] = o;
                }
            }
        }
        if (MODE == 1) {
            __syncthreads();
            for (int s = wave; s < n; s += 8) { const int t = t0 + ts + s; const int row = sample ? ROW_SAMPLE + b * 4 + t : prow(b, t);
                float o = OBUF[s * 64 + lane]; if (BR == 0) o += Dh * ACT[s * 256 + 192 + lane];
                const float ms = wave_sum(o * o, lane) * (1.f / 64.f);
                const float z = bf2f(U[(size_t)row * NU + zcol + lane]);
                MIX[(size_t)row * 1024 + mixcol + lane] = f2bf(o * __builtin_amdgcn_rsqf(ms + RMS_EPS) * gn * silu(z)); }
        }
    }
    if (MODE == 0 || sample) {
        float* dst = MODE == 0 ? sloc : a.out + (BR == 0 ? O_SSSD : (BR == 1 ? O_SGDN : O_SHG)) + (size_t)((l * 128 + b) * 4 + h) * 4096;
        __syncthreads();
#pragma unroll
        for (int i = 0; i < 8; ++i) SBUF[(kq * 8 + i) * 65 + v] = S[i];
        if (MODE == 0 && BR == 1) {
#pragma unroll
            for (int i = 0; i < 8; ++i) SBUF2[(kq * 8 + i) * 65 + v] = S2[i]; }
        __syncthreads();
        for (int idx = tid; idx < 4096; idx += 512) dst[idx] = SBUF[(idx >> 6) * 65 + (idx & 63)];
        if (MODE == 0 && BR == 1) { float* pd = (float*)(a.ws + WS_PG) + (size_t)(bh * NCH + c) * 4096; for (int idx = tid; idx < 4096; idx += 512) pd[idx] = SBUF2[(idx >> 6) * 65 + (idx & 63)]; }
        if (MODE == 0 && BR == 0 && tid == 0) ((float*)(a.ws + WS_DS))[bh * NCH + c] = decprod;
        if (MODE == 0 && BR == 2 && v == 0) {
#pragma unroll
            for (int i = 0; i < 8; ++i) ((float*)(a.ws + WS_DH))[(bh * NCH + c) * 64 + kq * 8 + i] = S2[i]; }
    }
}

constexpr int L5_CRE = 0, L5_CIM = 4352, L5_UB = 8704, L5_HB = 16896;
static_assert(L5_HB + 8 * 16 * 132 * 4 <= 131072, "lds5");
template <int MODE>
__device__ __forceinline__ void s5_task(CArgs& a, unsigned char* ldsg, const int l, const bool sample, const int g, const int c) {
    MK_LAS unsigned char* lds = (MK_LAS unsigned char*)ldsg;
    lfloat* CRE = (lfloat*)(lds + L5_CRE); lfloat* CIM = (lfloat*)(lds + L5_CIM);
    const int tid = otid(), lane = tid & 63, wave = tid >> 6;
    lfloat* UB = (lfloat*)(lds + L5_UB) + wave * 256; lfloat* HB = (lfloat*)(lds + L5_HB) + wave * 16 * 132;
    const bf16_t* U = (const bf16_t*)(a.ws + WS_U); bf16_t* Y5 = (bf16_t*)(a.ws + WS_Y5);
    MK_OPQ(U); MK_OPQ(Y5);
    const int b = sample ? c * 8 + wave : wave, nsteps = sample ? TS : CL, t0 = sample ? 0 : c * CL, lg = l * 16 + g;
    const float dt = __expf(a.in[I_LOGDT][lg]); const float lr = a.in[I_LAMR][lg * 64 + lane], li = a.in[I_LAMI][lg * 64 + lane];
    const float mag = __expf(lr * dt); float sn, cs; { float rv = li * dt * 0.15915494309189535f; rv -= rintf(rv); sn = __builtin_amdgcn_sinf(rv); cs = __builtin_amdgcn_cosf(rv); }
    const float lbr = mag * cs, lbi = mag * sn, den = lr * lr + li * li, nr = lbr - 1.f;
    const float rden = __builtin_amdgcn_rcpf(den); const float cr = (nr * lr + lbi * li) * rden, ci = (lbi * lr - nr * li) * rden;
    float bbr[16], bbi[16];
    { const f32x4* pr = (const f32x4*)(a.in[I_BR] + (size_t)(lg * 64 + lane) * 16); const f32x4* pi = (const f32x4*)(a.in[I_BI] + (size_t)(lg * 64 + lane) * 16);
#pragma unroll
        for (int j = 0; j < 4; ++j) { const f32x4 r = pr[j], im = pi[j];
#pragma unroll
            for (int k = 0; k < 4; ++k) { bbr[j * 4 + k] = cr * r[k] - ci * im[k]; bbi[j * 4 + k] = cr * im[k] + ci * r[k]; } } }
    __syncthreads();
    if (MODE == 1) { for (int idx = tid; idx < 1024; idx += 512) { const int q = idx >> 6, n = idx & 63; CRE[q * 68 + n] = a.in[I_CR][(size_t)lg * 1024 + idx]; CIM[q * 68 + n] = a.in[I_CI][(size_t)lg * 1024 + idx]; } }
    float* h5 = (float*)(a.ws + WS_H5) + (size_t)((b * 16 + g) * NCH + c) * 128;
    float hr = 0.f, hi = 0.f;
    if (MODE == 1) { if (sample) { hr = a.in[I_SS5R][(size_t)((l * 128 + b) * 16 + g) * 64 + lane]; hi = a.in[I_SS5I][(size_t)((l * 128 + b) * 16 + g) * 64 + lane]; } else { hr = h5[lane]; hi = h5[64 + lane]; } }
    __syncthreads();
    const int tt = lane >> 2, qq = lane & 3;
    f32x4 dv = {0.f, 0.f, 0.f, 0.f};
    if (MODE == 1) dv = *(const f32x4*)(a.in[I_S5D] + lg * 16 + qq * 4);
    for (int ts = 0; ts < nsteps; ts += 16) {
        const int n = (nsteps - ts) < 16 ? (nsteps - ts) : 16;
        { f32x4 uv = {0.f, 0.f, 0.f, 0.f};
          if (tt < n) { const int t = t0 + ts + tt; const int row = sample ? ROW_SAMPLE + b * 4 + t : prow(b, t); const u32x2 w = *(const u32x2*)(U + (size_t)row * NU + UC_UB + g * 16 + qq * 4);
              uv[0] = __uint_as_float(w.x << 16); uv[1] = __uint_as_float(w.x & 0xffff0000u); uv[2] = __uint_as_float(w.y << 16); uv[3] = __uint_as_float(w.y & 0xffff0000u); }
          *(lf32x4*)(UB + tt * 16 + qq * 4) = uv; }
        __builtin_amdgcn_wave_barrier(); asm volatile("s_waitcnt lgkmcnt(0)" ::: "memory");
        for (int s = 0; s < n; ++s) {
            float bur = 0.f, bui = 0.f;
#pragma unroll
            for (int j = 0; j < 4; ++j) { const f32x4 uu = *(const lf32x4*)(UB + s * 16 + j * 4);
#pragma unroll
                for (int k = 0; k < 4; ++k) { bur += bbr[j * 4 + k] * uu[k]; bui += bbi[j * 4 + k] * uu[k]; } }
            const float nhr = lbr * hr - lbi * hi + bur, nhi = lbr * hi + lbi * hr + bui; hr = nhr; hi = nhi;
            if (MODE == 1) { HB[s * 132 + lane] = hr; HB[s * 132 + 64 + lane] = hi; }
        }
        if (MODE == 1) {
            __builtin_amdgcn_wave_barrier(); asm volatile("s_waitcnt lgkmcnt(0)" ::: "memory");
            float acc[4] = {0.f, 0.f, 0.f, 0.f};
            if (tt < n) {
#pragma unroll 4
                for (int n4 = 0; n4 < 16; ++n4) { const f32x4 hre = *(const lf32x4*)(HB + tt * 132 + n4 * 4), him = *(const lf32x4*)(HB + tt * 132 + 64 + n4 * 4);
#pragma unroll
                    for (int j = 0; j < 4; ++j) { const f32x4 cre = *(const lf32x4*)(CRE + (qq * 4 + j) * 68 + n4 * 4), cim = *(const lf32x4*)(CIM + (qq * 4 + j) * 68 + n4 * 4);
#pragma unroll
                        for (int k = 0; k < 4; ++k) acc[j] += cre[k] * hre[k] - cim[k] * him[k]; } }
                const f32x4 uu = *(const lf32x4*)(UB + tt * 16 + qq * 4);
                const int t = t0 + ts + tt; const int row = sample ? ROW_SAMPLE + b * 4 + t : prow(b, t);
                u32x2 w; w.x = pk2(gelu_tanh(acc[0] + dv[0] * uu[0]), gelu_tanh(acc[1] + dv[1] * uu[1])); w.y = pk2(gelu_tanh(acc[2] + dv[2] * uu[2]), gelu_tanh(acc[3] + dv[3] * uu[3]));
                *(u32x2*)(Y5 + (size_t)row * 256 + g * 16 + qq * 4) = w;
            }
            __builtin_amdgcn_wave_barrier(); asm volatile("s_waitcnt lgkmcnt(0)" ::: "memory");
        }
    }
    if (MODE == 0) { h5[lane] = hr; h5[64 + lane] = hi; }
    else if (sample) { a.out[O_SS5R + (size_t)((l * 128 + b) * 16 + g) * 64 + lane] = hr; a.out[O_SS5I + (size_t)((l * 128 + b) * 16 + g) * 64 + lane] = hi; }
}

__device__ __forceinline__ void conv_copy_task(CArgs& a, int l, int part, int nparts) {
    const bf16_t* U = (const bf16_t*)(a.ws + WS_U); MK_OPQ(U); float* outp = a.out; MK_OPQ(outp);
    const int total = 136 * 3 * 1280;
    for (int idx = part * 512 + otid(); idx < total; idx += nparts * 512) {
        const int sb = idx / (3 * 1280), r = idx - sb * 3 * 1280, j = r / 1280, ch = r - j * 1280;
        const bool smp = sb >= 8; const int b = smp ? sb - 8 : sb;
        const int row = smp ? ROW_SAMPLE + b * 4 + 1 + j : prow(b, TP - 3 + j);
        if (ch < 512) { const float val = bf2f(U[(size_t)row * NU + UC_XBC + ch]); a.out[(smp ? O_SSSDC + (size_t)(l * 128 + b) * SZ_SC : O_PSSDC + (size_t)(l * 8 + b) * SZ_SC) + j * 512 + ch] = val; }
        else { const int c2 = ch - 512; const float val = bf2f(U[(size_t)row * NU + UC_QKV + c2]); a.out[(smp ? O_SGDNC + (size_t)(l * 128 + b) * SZ_GC : O_PGDNC + (size_t)(l * 8 + b) * SZ_GC) + j * 768 + c2] = val; }
    }
}

__device__ __forceinline__ void pass2_gdn(CArgs& a, unsigned char* ldsg, int l, int bh, int vb) {
    MK_LAS unsigned char* lds = (MK_LAS unsigned char*)ldsg;
    lfloat* PL = (lfloat*)lds; lfloat* SL = (lfloat*)(lds + 64 * 68 * 4);
    const int tid = otid(), k = tid >> 3, vv = tid & 7;
    float* sg = (float*)(a.ws + WS_SG) + (size_t)bh * NCH * 4096; const float* pg = (const float*)(a.ws + WS_PG) + (size_t)bh * NCH * 4096;
    __syncthreads();
    SL[k * 8 + vv] = 0.f;
    float cur = 0.f;
    for (int c = 0; c < NCH; ++c) {
        const float* pc = pg + (size_t)c * 4096;
        { const f32x4 p0 = *(const f32x4*)(pc + tid * 8), p1 = *(const f32x4*)(pc + tid * 8 + 4); const int r = (tid * 8) >> 6, cc = (tid * 8) & 63;
          *(lf32x4*)(PL + r * 68 + cc) = p0; *(lf32x4*)(PL + r * 68 + cc + 4) = p1; }
        float* slot = sg + (size_t)c * 4096 + k * 64 + vb * 8 + vv;
        float acc = *slot;
        __syncthreads();
#pragma unroll 4
        for (int j4 = 0; j4 < 16; ++j4) { const f32x4 p = *(const lf32x4*)(PL + k * 68 + j4 * 4);
#pragma unroll
            for (int q = 0; q < 4; ++q) acc += p[q] * SL[(j4 * 4 + q) * 8 + vv]; }
        *slot = cur;
        __syncthreads();
        cur = acc; SL[k * 8 + vv] = acc;
    }
    const int b = bh >> 2, h = bh & 3;
    a.out[O_PGDN + (size_t)((l * 8 + b) * 4 + h) * 4096 + k * 64 + vb * 8 + vv] = cur;
}
__device__ __forceinline__ void pass2_diag(CArgs& a, int l, int br  , int bh, int quarter) {
    float* ss = (float*)(a.ws + (br == 0 ? WS_SS : WS_SH)) + (size_t)bh * NCH * 4096;
    const float* ds = (const float*)(a.ws + WS_DS) + bh * NCH; const float* dh = (const float*)(a.ws + WS_DH) + (size_t)bh * NCH * 64;
    const int e = quarter * 1024 + otid() * 2, k = e >> 6;
    float c0 = 0.f, c1 = 0.f; asm volatile("" : "+v"(c0), "+v"(c1));
    for (int c = 0; c < NCH; ++c) { float* slot = ss + (size_t)c * 4096 + e; const float l0 = slot[0], l1 = slot[1]; const float dec = br == 0 ? ds[c] : dh[c * 64 + k];
        slot[0] = c0; slot[1] = c1; c0 = dec * c0 + l0; c1 = dec * c1 + l1; }
    const int b = bh >> 2, h = bh & 3; float* o = a.out + (br == 0 ? O_PSSD : O_PHG) + (size_t)((l * 8 + b) * 4 + h) * 4096 + e;
    o[0] = c0; o[1] = c1;
}
__device__ __forceinline__ void pass2_s5(CArgs& a, int l, int part) {
    const int e = part * 512 + otid(), bg = e >> 6, n = e & 63, b = bg >> 4, g = bg & 15, lg = l * 16 + g;
    const float dt = __expf(a.in[I_LOGDT][lg]); const float lr = a.in[I_LAMR][lg * 64 + n], li = a.in[I_LAMI][lg * 64 + n];
    const float mag = __expf(lr * dt); float sn, cs; { float rv = li * dt * 0.15915494309189535f; rv -= rintf(rv); sn = __builtin_amdgcn_sinf(rv); cs = __builtin_amdgcn_cosf(rv); }
    const float lbr = mag * cs, lbi = mag * sn;
    float pr = 1.f, pi = 0.f;
    for (int i = 0; i < CL; ++i) { const float t = pr * lbr - pi * lbi; pi = pr * lbi + pi * lbr; pr = t; }
    float* h5 = (float*)(a.ws + WS_H5) + (size_t)bg * NCH * 128;
    float hr = 0.f, hi = 0.f; asm volatile("" : "+v"(hr), "+v"(hi));
    for (int c = 0; c < NCH; ++c) { float* s = h5 + c * 128; const float l0 = s[n], l1 = s[64 + n]; s[n] = hr; s[64 + n] = hi;
        const float t = pr * hr - pi * hi + l0; hi = pr * hi + pi * hr + l1; hr = t; }
    a.out[O_PS5R + (size_t)((l * 8 + b) * 16 + g) * 64 + n] = hr; a.out[O_PS5I + (size_t)((l * 8 + b) * 16 + g) * 64 + n] = hi;
}

__device__ __forceinline__ void phase_mixer(CArgs& a, unsigned char* lds, int l, int which  ) {
    const int ntasks = which == 1 ? 3600 : 1792;
    for (int task = obid(); task < ntasks; task += gridDim.x) {
        int kind, p0, p1; bool sample = false;
        if (which == 1) {
            if (task < 1536) { kind = task >> 9; p0 = (task & 511) >> 4; p1 = task & 15; }
            else if (task < 1792) { kind = 3; p0 = (task - 1536) >> 4; p1 = task & 15; }
            else if (task < 3328) { const int r = task - 1792; kind = 4 + (r >> 9); p0 = r & 511; p1 = 0; sample = true; }
            else if (task < 3584) { const int r = task - 3328; kind = 7; p0 = r >> 4; p1 = r & 15; sample = true; }
            else { kind = 8; p0 = task - 3584; p1 = 0; }
        } else {
            if (task < 1536) { kind = 4 + (task >> 9); p0 = (task & 511) >> 4; p1 = task & 15; }
            else { kind = 7; p0 = (task - 1536) >> 4; p1 = task & 15; }
        }
        switch (kind) {
            case 0: rec_task<1, 0>(a, lds, l, false, p0 >> 2, p0 & 3, p1); break;
            case 1: rec_task<0, 0>(a, lds, l, false, p0 >> 2, p0 & 3, p1); break;
            case 2: rec_task<2, 0>(a, lds, l, false, p0 >> 2, p0 & 3, p1); break;
            case 3: s5_task<0>(a, lds, l, false, p0, p1); break;
            case 4: rec_task<1, 1>(a, lds, l, sample, p0 >> 2, p0 & 3, p1); break;
            case 5: rec_task<0, 1>(a, lds, l, sample, p0 >> 2, p0 & 3, p1); break;
            case 6: rec_task<2, 1>(a, lds, l, sample, p0 >> 2, p0 & 3, p1); break;
            case 7: s5_task<1>(a, lds, l, sample, p0, p1); break;
            default: conv_copy_task(a, l, p0, 16); break;
        }
    }
}
__device__ __forceinline__ void phase_pass2(CArgs& a, unsigned char* lds, int l) {
    for (int task = obid(); task < 528; task += gridDim.x) {
        if (task < 256) pass2_gdn(a, lds, l, task >> 3, task & 7);
        else if (task < 384) pass2_diag(a, l, 0, (task - 256) >> 2, task & 3);
        else if (task < 512) pass2_diag(a, l, 2, (task - 384) >> 2, task & 3);
        else pass2_s5(a, l, task - 512);
    }
}

template <class Epi>
__device__ __forceinline__ void run_gemm(unsigned char* lds, const bf16_t* A, const bf16_t* Bt, int M, int N, int K, const Epi& E) {
    pg8::Gemm g; g.A = A; g.Bt = Bt; g.M = M; g.N = N; g.K = K;
    pg8::StaticOrder S; S.init(M, N, gridDim.x, obid());
    pg8::gemm_phase<Epi, pg8::StaticOrder, false>((PG8_LAS unsigned char*)lds, g, S, E, nullptr);
}

constexpr int N_PHASES = 1 + 7 * DEPTH;
#ifndef MK_ONE_LAUNCH
#define MK_ONE_LAUNCH 1
#endif

__global__ void __launch_bounds__(512, 2) hybrid_fwd(Args a_in) {
    extern __shared__ __attribute__((aligned(16))) unsigned char lds_[];
    const int ph_lo = a_in.ph_lo, ph_hi = a_in.ph_hi;
    for (int ph = ph_lo; ph < ph_hi; ++ph) {
        if (ph > ph_lo) {
#if MK_ONE_LAUNCH
            cg::this_grid().sync();
#endif
        }
        CArgs* ap = (CArgs*)__builtin_amdgcn_kernarg_segment_ptr();
        asm volatile("" : "+s"(ap));
        CArgs& a = *ap;
        unsigned char* lds = lds_;
        if (ph == 0) { phase_prologue(a, lds); continue; }
        const int l = (ph - 1) / 7, sub = (ph - 1) % 7;
        switch (sub) {
            case 0: { EpiU E; E.U = (bf16_t*)(a.ws + WS_U); E.USM = (float*)(a.ws + WS_USM);
                      run_gemm(lds, (const bf16_t*)(a.ws + WS_XB), (const bf16_t*)(a.ws + WS_WTIN) + (size_t)l * NU_PAD * 1024, MP, NU_PAD, 1024, E); } break;
#ifndef MK_NOMIX
            case 1: phase_mixer(a, lds, l, 1); break;
            case 2: phase_pass2(a, lds, l); break;
            case 3: phase_mixer(a, lds, l, 3); break;
#endif
            case 4: { EpiGlu E; E.Y5 = (const bf16_t*)(a.ws + WS_Y5); E.U = (const bf16_t*)(a.ws + WS_U); E.bias = a.in[I_GLUB] + l * 256; E.MIX = (bf16_t*)(a.ws + WS_XB);
                      run_gemm(lds, (const bf16_t*)(a.ws + WS_Y5), (const bf16_t*)(a.ws + WS_WTGLU) + (size_t)l * 256 * 256, MP, 256, 256, E); } break;
            case 5: { EpiOut E; E.out = a.out; E.xmeta = (float*)(a.ws + WS_XMETA);
                      run_gemm(lds, (const bf16_t*)(a.ws + WS_XB), (const bf16_t*)(a.ws + WS_WTOUT) + (size_t)l * 1024 * 1024, MP, 1024, 1024, E); } break;
            default: phase_ln(a, l); break;
        }
    }
}
}

extern "C" void kernel_launch(void* const* d_in, const int* in_sizes, int n_in, void* d_out, int out_size, void* d_ws, size_t ws_size, hipStream_t stream) {
    using namespace mk;
    static int grid = 0;
    if (!grid) {
        int dev = 0, cus = 0, per_cu = 0;
        hipGetDevice(&dev); hipDeviceGetAttribute(&cus, hipDeviceAttributeMultiprocessorCount, dev);
        hipFuncSetAttribute((const void*)hybrid_fwd, hipFuncAttributeMaxDynamicSharedMemorySize, LDS_BYTES);
        hipOccupancyMaxActiveBlocksPerMultiprocessor(&per_cu, (const void*)hybrid_fwd, 512, LDS_BYTES);
        if (per_cu < 1) { fprintf(stderr, "kernel_launch: occupancy query says %d blocks/CU\n", per_cu); per_cu = 1; }
        grid = cus;
        if (n_in != N_IN || (size_t)out_size != O_END || ws_size < WS_END) fprintf(stderr, "kernel_launch: unexpected shapes n_in %d out %d ws %zu\n", n_in, out_size, ws_size);
    }
    Args a{};
    for (int i = 0; i < N_IN; ++i) a.in[i] = (const float*)d_in[i];
    a.out = (float*)d_out; a.ws = (unsigned char*)d_ws;
#if MK_ONE_LAUNCH
    a.ph_lo = 0; a.ph_hi = N_PHASES;
    void* args[] = {&a};
    hipError_t e = hipLaunchCooperativeKernel((const void*)hybrid_fwd, dim3(grid), dim3(512), args, LDS_BYTES, stream);
    if (e != hipSuccess) fprintf(stderr, "cooperative launch failed: %s (grid %d)\n", hipGetErrorString(e), grid);
#else
    for (int ph = 0; ph < N_PHASES; ++ph) { a.ph_lo = ph; a.ph_hi = ph + 1; hipLaunchKernelGGL(hybrid_fwd, dim3(grid), dim3(512), LDS_BYTES, stream, a); }
#endif
}
```

```cpp
#include <hip/hip_runtime.h>
#include <hip/hip_cooperative_groups.h>
#include <cstdio>
namespace cg = cooperative_groups;
namespace pg8 {
#define PG8_LAS __attribute__((address_space(3)))
typedef unsigned short bf16_t;
typedef short bf16x8 __attribute__((ext_vector_type(8)));
typedef float f32x4 __attribute__((ext_vector_type(4)));
typedef unsigned u32x4 __attribute__((ext_vector_type(4)));
constexpr int BM = 256, BK = 64, HALF = 128, HTB = HALF * BK * 2  , STAGE_BYTES = 8 * HTB, NXCD = 8, WGM = 8;

__host__ __device__ __forceinline__ int lds_byte(int r, int c) { const int st = (r >> 4) * 2 + (c >> 5), rr = r & 15, cc = c & 31, ob = rr * 64 + cc * 2; return st * 1024 + (ob ^ (((ob >> 9) & 1) << 5)); }
__host__ __device__ __forceinline__ void stage_rc(int b, int& R, int& C) { const int st = b / 1024, sb = b % 1024, swz = sb ^ (((sb >> 9) & 1) << 5); R = (st >> 1) * 16 + swz / 64; C = (st & 1) * 32 + (swz % 64) / 2; }
__host__ __device__ __forceinline__ int perm32(int rho) { const int n = rho >> 4, i = rho & 15; return 8 * (i >> 2) + 4 * n + (i & 3); }

struct Unit { int pm, pn; };
struct Gemm { const bf16_t* A; const bf16_t* Bt; int M, N, K; };

struct StaticOrder {
    int nM, nN, nwg, G, c;
    __host__ __device__ void init(int M, int N, int G_, int c_) { nM = M / BM; nN = N / BM; nwg = nM * nN; G = G_; c = c_; }
    __host__ __device__ bool next(int i, Unit& u) const {
        const int L = i * G + c; if (L >= nwg) return false;
        int wgid = L; { const int q = nwg / NXCD, r = nwg % NXCD, xcd = wgid % NXCD, off = wgid / NXCD; wgid = (xcd < r ? xcd * (q + 1) : r * (q + 1) + (xcd - r) * q) + off; }
        const int nig = WGM * nN, gid = wgid / nig, fm = gid * WGM, gsz = (nM - fm) < WGM ? (nM - fm) : WGM;
        u.pm = fm + ((wgid % nig) % gsz); u.pn = (wgid % nig) / gsz; return true;
    }
    __device__ __forceinline__ void a_ready(const Unit&) const {}
    __device__ __forceinline__ void done(const Unit&) const {}
};
__device__ __forceinline__ unsigned cvt_pk_bf16(float lo, float hi) { unsigned r; asm volatile("v_cvt_pk_bf16_f32 %0, %1, %2" : "=v"(r) : "v"(lo), "v"(hi)); return r; }
typedef float f32x2 __attribute__((ext_vector_type(2)));
template <class Epi, class Sched, bool STAMP = false>
__device__ __forceinline__ void gemm_phase(PG8_LAS unsigned char* lds, const Gemm g, const Sched& S, const Epi& E, unsigned long long* stamps) {
    int tid_ = threadIdx.x; asm volatile("" : "+v"(tid_)); const int tid = tid_, wid = __builtin_amdgcn_readfirstlane(tid >> 6), lane = tid & 63, wr = wid >> 2, wc = wid & 3, fr = lane & 15, fq = lane >> 4;
    const int K = g.K, nt = K / BK;
    int ts_lo = 0, ts_hi = 0, nts = 0; const unsigned long long rt_entry = STAMP ? (unsigned long long)wall_clock64() : 0ull;
#define PG8_STAMP() do { if (STAMP && wid == 0 && nts < 64) { const unsigned long long _c = (unsigned long long)clock64(); \
        ts_lo = (lane == nts) ? (int)(unsigned)_c : ts_lo; ts_hi = (lane == nts) ? (int)(unsigned)(_c >> 32) : ts_hi; ++nts; } } while (0)
    PG8_STAMP();
    unsigned voffA[2], voffB[2];
#pragma unroll
    for (int i = 0; i < 2; ++i) { int R, C; stage_rc(tid * 16 + i * 8192, R, C); const int Rb = Epi::PERM ? ((R & ~31) + perm32(R & 31)) : R;
        voffA[i] = (unsigned)(R * K + C) * 2u; voffB[i] = (unsigned)(Rb * K + C) * 2u; }
    const size_t kstep = (size_t)(BK * 2);
    const size_t hstep = (size_t)HALF * K * 2;
    const size_t tstep = 2 * hstep;
    const unsigned ldsw = (unsigned)wid * 1024u;
    const int aoff = lds_byte(wr * 64 + fr, fq * 8), boff = lds_byte(wc * 32 + fr, fq * 8);
#define PG8_SA(b, h) (((b) * 2 + (h)) * HTB)
#define PG8_SB(b, h) ((4 + (b) * 2 + (h)) * HTB)
#define PG8_STAGE(bufoff, gbase, voff) do { _Pragma("unroll") for (int _i = 0; _i < 2; ++_i) \
        __builtin_amdgcn_global_load_lds((const unsigned*)((const char*)(gbase) + (voff)[_i]), (PG8_LAS unsigned*)(lds + (bufoff) + ldsw + _i * 8192), 16, 0, 0); } while (0)
#define PG8_LDA(dst, b, h) do { _Pragma("unroll") for (int m = 0; m < 4; ++m) _Pragma("unroll") for (int k = 0; k < 2; ++k) dst[m][k] = *(const PG8_LAS bf16x8*)(lds + PG8_SA(b, h) + aoff + m * 2048 + k * 1024); } while (0)
#define PG8_LDB(dst, b, h) do { _Pragma("unroll") for (int n = 0; n < 2; ++n) _Pragma("unroll") for (int k = 0; k < 2; ++k) dst[n][k] = *(const PG8_LAS bf16x8*)(lds + PG8_SB(b, h) + boff + n * 2048 + k * 1024); } while (0)
#define PG8_MMA(ai, bj, At, Bt) do { __builtin_amdgcn_s_setprio(1); _Pragma("unroll") for (int m = 0; m < 4; ++m) _Pragma("unroll") for (int n = 0; n < 2; ++n) _Pragma("unroll") for (int k = 0; k < 2; ++k) \
        acc[ai][bj][m][n] = __builtin_amdgcn_mfma_f32_16x16x32_bf16(Bt[n][k], At[m][k], acc[ai][bj][m][n], 0, 0, 0); __builtin_amdgcn_s_setprio(0); } while (0)
#define PG8_WAIT_V(n) asm volatile("s_waitcnt vmcnt(" #n ")" ::: "memory")
#define PG8_WAIT_L(n) asm volatile("s_waitcnt lgkmcnt(" #n ")" ::: "memory")
#define PG8_BAR __builtin_amdgcn_s_barrier()
#define PG8_SCHED __builtin_amdgcn_sched_barrier(0)
    Unit cur, nxt; int ui = 0;
    if (!S.next(0, cur)) return;
    f32x4 acc[2][2][4][2];
#pragma unroll
    for (int a = 0; a < 2; ++a)
#pragma unroll
        for (int b = 0; b < 2; ++b)
#pragma unroll
            for (int m = 0; m < 4; ++m)
#pragma unroll
                for (int n = 0; n < 2; ++n) acc[a][b][m][n] = (f32x4){0.f, 0.f, 0.f, 0.f};
    bf16x8 At[4][2], B0[2][2], B1[2][2];
    const char* cA = (const char*)g.A + (size_t)cur.pm * tstep; const char* cB = (const char*)g.Bt + (size_t)cur.pn * tstep;
    S.a_ready(cur);
    PG8_STAGE(PG8_SB(0, 0), cB, voffB); PG8_STAGE(PG8_SA(0, 0), cA, voffA); PG8_STAGE(PG8_SB(0, 1), cB + hstep, voffB); PG8_STAGE(PG8_SA(0, 1), cA + hstep, voffA);
    if (wr == 1) PG8_BAR;
    PG8_WAIT_V(4); PG8_BAR;
    PG8_STAGE(PG8_SB(1, 0), cB + kstep, voffB); PG8_STAGE(PG8_SA(1, 0), cA + kstep, voffA); PG8_STAGE(PG8_SB(1, 1), cB + hstep + kstep, voffB);
    PG8_WAIT_V(6); PG8_BAR;
    PG8_STAMP();
    for (;;) {
        const bool has_next = S.next(ui + 1, nxt);
        const char* nA = has_next ? (const char*)g.A + (size_t)nxt.pm * tstep : cA; const char* nB = has_next ? (const char*)g.Bt + (size_t)nxt.pn * tstep : cB;
        for (int t = 0; t < nt; t += 2) {
            const bool last = (t == nt - 2);
            const char* a1 = cA + (size_t)(t + 1) * kstep;
            const char* a2 = last ? nA : cA + (size_t)(t + 2) * kstep; const char* b2 = last ? nB : cB + (size_t)(t + 2) * kstep;
            const char* a3 = a2 + kstep; const char* b3 = b2 + kstep;
            if (last && has_next) S.a_ready(nxt);
            PG8_LDB(B0, 0, 0); PG8_SCHED; PG8_LDA(At, 0, 0); PG8_STAGE(PG8_SA(1, 1), a1 + hstep, voffA);
            PG8_WAIT_L(8); PG8_BAR; PG8_WAIT_L(0); PG8_MMA(0, 0, At, B0); PG8_BAR; PG8_SCHED;
            PG8_LDB(B1, 0, 1); PG8_STAGE(PG8_SB(0, 0), b2, voffB);
            PG8_BAR; PG8_WAIT_L(0); PG8_MMA(0, 1, At, B1); PG8_BAR;
            PG8_LDA(At, 0, 1); PG8_STAGE(PG8_SA(0, 0), a2, voffA);
            PG8_BAR; PG8_WAIT_L(0); PG8_MMA(1, 0, At, B0); PG8_BAR; PG8_SCHED;
            PG8_STAGE(PG8_SB(0, 1), b2 + hstep, voffB);
            PG8_WAIT_V(6); PG8_BAR; PG8_MMA(1, 1, At, B1); PG8_BAR;
            PG8_LDB(B0, 1, 0); PG8_SCHED; PG8_LDA(At, 1, 0); PG8_STAGE(PG8_SA(0, 1), a2 + hstep, voffA);
            PG8_WAIT_L(8); PG8_BAR; PG8_WAIT_L(0); PG8_MMA(0, 0, At, B0); PG8_BAR; PG8_SCHED;
            PG8_LDB(B1, 1, 1); PG8_STAGE(PG8_SB(1, 0), b3, voffB);
            PG8_BAR; PG8_WAIT_L(0); PG8_MMA(0, 1, At, B1); PG8_BAR;
            PG8_LDA(At, 1, 1); PG8_STAGE(PG8_SA(1, 0), a3, voffA);
            PG8_BAR; PG8_WAIT_L(0); PG8_MMA(1, 0, At, B0); PG8_BAR; PG8_SCHED;
            PG8_STAGE(PG8_SB(1, 1), b3 + hstep, voffB);
            PG8_WAIT_V(6); PG8_BAR; PG8_MMA(1, 1, At, B1); PG8_BAR;
        }
        PG8_STAMP();
        if constexpr (!Epi::AFTER_DRAIN) { E(acc, cur, wr, wc, fr, fq); S.done(cur); }
        PG8_STAMP();
        if (!has_next) break;
#pragma unroll
        for (int a = 0; a < 2; ++a)
#pragma unroll
            for (int b = 0; b < 2; ++b)
#pragma unroll
                for (int m = 0; m < 4; ++m)
#pragma unroll
                    for (int n = 0; n < 2; ++n) acc[a][b][m][n] = (f32x4){0.f, 0.f, 0.f, 0.f};
        cur = nxt; cA = nA; cB = nB; ++ui;
    }
    PG8_WAIT_V(0);
    if (wr == 0) PG8_BAR;
    PG8_BAR;
    if constexpr (Epi::AFTER_DRAIN) { E.fused(acc, cur, wr, wc, fr, fq, lds, wid, lane); S.done(cur); }
    PG8_STAMP();
    if (STAMP && wid == 0) { stamps[lane] = lane < nts ? (((unsigned long long)(unsigned)ts_hi << 32) | (unsigned)ts_lo) : 0ull;
        if (lane == 62) stamps[62] = rt_entry; if (lane == 63) stamps[63] = (unsigned long long)wall_clock64(); }
#undef PG8_STAMP
#undef PG8_SA
#undef PG8_SB
#undef PG8_STAGE
#undef PG8_LDA
#undef PG8_LDB
#undef PG8_MMA
#undef PG8_WAIT_V
#undef PG8_WAIT_L
#undef PG8_BAR
#undef PG8_SCHED
}
}

namespace mk {
using pg8::bf16_t; using pg8::f32x4; using pg8::u32x4; using pg8::Unit; using pg8::cvt_pk_bf16;
typedef unsigned u32x2 __attribute__((ext_vector_type(2)));
using pg8::f32x2;
#define MK_LAS __attribute__((address_space(3)))
typedef MK_LAS float lfloat;
typedef MK_LAS f32x4 lf32x4;

constexpr int D = 1024, DEPTH = 4, TP = 2064, BP = 8, BS = 128, TS = 4;
constexpr int M_REAL = 17024, MP = 17152, ROW_SAMPLE = 16384, ROW_META = 16896;
constexpr int D_IN = 3340, NU = 3328, NU_PAD = 3584;
constexpr int CL = 129, NCH = 16, ST = 43;
constexpr int UC_ZA = 0, UC_XBC = 256, UC_ZB = 768, UC_UB = 1024, UC_ZC = 1280, UC_QKV = 1536, UC_ZD = 2304, UC_QD = 2560, UC_FD = 2816, UC_ID = 3072;
constexpr float DN_ALPHA = 1.6817928305074290f;
constexpr float LN_EPS = 1e-5f, RMS_EPS = 1e-6f, L2_EPS = 1e-6f;

enum { I_XP = 0, I_XS, I_SSSD, I_SSSDC, I_SS5R, I_SS5I, I_SGDN, I_SGDNC, I_SHG, I_META, I_LNIG, I_LNIB, I_WIN, I_SCW, I_SCB, I_SDTB, I_SALOG, I_SD, I_SNG,
       I_LAMR, I_LAMI, I_LOGDT, I_BR, I_BI, I_CR, I_CI, I_S5D, I_GLUW, I_GLUB, I_GCW, I_GCB, I_GALOG, I_GDTB, I_GNG, I_HLB, I_HNG, I_WOUT, I_LNG, I_LNB, N_IN };

constexpr size_t O_YP = 0, O_YS = O_YP + (size_t)8 * 2048 * 1024, O_PSSD = O_YS + (size_t)128 * 4 * 1024;
constexpr size_t SZ_ST = 4 * 64 * 64, SZ_SC = 3 * 512, SZ_S5 = 16 * 64, SZ_GC = 3 * 768;
constexpr size_t O_PSSDC = O_PSSD + 4 * 8 * SZ_ST, O_PS5R = O_PSSDC + 4 * 8 * SZ_SC, O_PS5I = O_PS5R + 4 * 8 * SZ_S5, O_PGDN = O_PS5I + 4 * 8 * SZ_S5,
                 O_PGDNC = O_PGDN + 4 * 8 * SZ_ST, O_PHG = O_PGDNC + 4 * 8 * SZ_GC, O_SSSD = O_PHG + 4 * 8 * SZ_ST, O_SSSDC = O_SSSD + 4 * 128 * SZ_ST,
                 O_SS5R = O_SSSDC + 4 * 128 * SZ_SC, O_SS5I = O_SS5R + 4 * 128 * SZ_S5, O_SGDN = O_SS5I + 4 * 128 * SZ_S5, O_SGDNC = O_SGDN + 4 * 128 * SZ_ST,
                 O_SHG = O_SGDNC + 4 * 128 * SZ_GC, O_END = O_SHG + 4 * 128 * SZ_ST;
static_assert(O_END == 47243264, "d_out size");

constexpr size_t WS_WTIN = 0;
constexpr size_t WS_WTOUT = WS_WTIN + (size_t)4 * NU_PAD * 1024 * 2;
constexpr size_t WS_WTGLU = WS_WTOUT + (size_t)4 * 1024 * 1024 * 2;
constexpr size_t WS_XB = WS_WTGLU + (size_t)4 * 256 * 256 * 2;
constexpr size_t WS_XMETA = WS_XB + (size_t)MP * 1024 * 2;
constexpr size_t WS_U = WS_XMETA + (size_t)128 * 1024 * 4;
constexpr size_t WS_USM = WS_U + (size_t)MP * NU * 2;
constexpr size_t WS_Y5 = WS_USM + (size_t)MP * 16 * 4;
constexpr size_t WS_SG = WS_Y5 + (size_t)MP * 256 * 2;
constexpr size_t WS_PG = WS_SG + (size_t)32 * 16 * 4096 * 4;
constexpr size_t WS_SS = WS_PG + (size_t)32 * 16 * 4096 * 4;
constexpr size_t WS_SH = WS_SS + (size_t)32 * 16 * 4096 * 4;
constexpr size_t WS_DS = WS_SH + (size_t)32 * 16 * 4096 * 4;
constexpr size_t WS_DH = WS_DS + 4096;
constexpr size_t WS_H5 = WS_DH + (size_t)32 * 16 * 64 * 4;
constexpr size_t WS_END = WS_H5 + (size_t)8 * 16 * 16 * 128 * 4;
constexpr size_t WS_CTL = WS_END;
constexpr size_t CTL_BYTES = 16384;
static_assert(WS_CTL + CTL_BYTES <= 268435456, "ws");
constexpr int L_BARST = 147456 - 16;

constexpr int LDS_BYTES = 147456;
constexpr int H_RAW = 0, H_ACT = 17664, H_ZB = 61696, H_SCAL = 67200, H_MISC = 67712, H_CWL = 67968, H_STRIDE = 71808, H_OBUF = H_RAW;
static_assert(H_ACT == (ST + 3) * 192 * 2 && H_ZB == H_ACT + ST * 256 * 4 && H_SCAL == H_ZB + ST * 64 * 2 && ST * 64 * 4 <= H_ACT && (2 * ST + 1) * 4 <= 512, "lds map");
static_assert(2 * 16640 <= H_ZB && 2 * H_STRIDE <= 147456 - 16, "lds");

struct Args { const float* in[N_IN]; float* out; unsigned char* ws; int ph_lo, ph_hi; };
typedef __attribute__((address_space(4))) const Args CArgs;

__device__ __forceinline__ int otid() { int t = threadIdx.x; asm volatile("" : "+v"(t)); return t; }
#define MK_OPQ(p) asm volatile("" : "+s"(p))
__device__ __forceinline__ int obid() { int t = blockIdx.x; asm volatile("" : "+s"(t)); return t; }
__device__ __forceinline__ float bf2f(bf16_t v) { return __uint_as_float(((unsigned)v) << 16); }
__device__ __forceinline__ bf16_t f2bf(float f) { unsigned u = __float_as_uint(f); return (bf16_t)((u + 0x7fffu + ((u >> 16) & 1u)) >> 16); }
__device__ __forceinline__ unsigned pk2(float lo, float hi) { return (unsigned)f2bf(lo) | ((unsigned)f2bf(hi) << 16); }
__device__ __forceinline__ float sigm(float x) { return __builtin_amdgcn_rcpf(1.f + __expf(-x)); }
__device__ __forceinline__ float silu(float x) { return x * __builtin_amdgcn_rcpf(1.f + __expf(-x)); }
__device__ __forceinline__ float softplus(float x) { const float e = __expf(x); return x > 15.f ? x : (e < 0.01f ? e * (1.f - e * (0.5f - e * 0.33333333f)) : __logf(1.f + e)); }
__device__ __forceinline__ float gelu_tanh(float x) { const float u = 0.7978845608028654f * (x + 0.044715f * x * x * x); const float t = __expf(2.f * u); return 0.5f * x * (2.f - 2.f * __builtin_amdgcn_rcpf(1.f + t)); }
__device__ __forceinline__ float wave_sum(float v, int lane) {
#pragma unroll
    for (int o = 1; o < 64; o <<= 1) v += __builtin_bit_cast(float, __builtin_amdgcn_ds_bpermute((lane ^ o) << 2, __builtin_bit_cast(int, v)));
    return v;
}
__device__ __forceinline__ float red8(float x) {
    x += __builtin_bit_cast(float, __builtin_amdgcn_update_dpp(0, __builtin_bit_cast(int, x), 0xB1, 0xF, 0xF, true));
    x += __builtin_bit_cast(float, __builtin_amdgcn_update_dpp(0, __builtin_bit_cast(int, x), 0x4E, 0xF, 0xF, true));
    x += __builtin_bit_cast(float, __builtin_amdgcn_update_dpp(0, __builtin_bit_cast(int, x), 0x141, 0xF, 0xF, true));
    return x;
}
__device__ __forceinline__ void lds_barrier() { asm volatile("s_waitcnt lgkmcnt(0)" ::: "memory"); __builtin_amdgcn_s_barrier(); asm volatile("" ::: "memory"); }
__device__ __forceinline__ int prow(int b, int t) { return t < 16 ? ROW_META + b * 16 + t : b * 2048 + t - 16; }
__device__ __forceinline__ float* xrow_ptr(CArgs& a, int row) { return row < ROW_META ? a.out + (size_t)row * D : (float*)(a.ws + WS_XMETA) + (size_t)(row - ROW_META) * D; }

__device__ __forceinline__ void transpose_item(const float* W, int ldw, int K, int k0, int ns0, bf16_t* WT, int nd0, lfloat* scr, int lane) {
#pragma unroll 8
    for (int i = 0; i < 32; ++i) { const int kk = 2 * i + (lane >> 5); scr[kk * 33 + (lane & 31)] = W[(size_t)(k0 + kk) * ldw + ns0 + (lane & 31)]; }
    __builtin_amdgcn_wave_barrier(); asm volatile("s_waitcnt lgkmcnt(0)" ::: "memory");
    const int c = lane & 7;
#pragma unroll
    for (int j = 0; j < 4; ++j) { const int n = (lane >> 3) + 8 * j; const lfloat* s = scr + (8 * c) * 33 + n;
        u32x4 o; o.x = pk2(s[0 * 33], s[1 * 33]); o.y = pk2(s[2 * 33], s[3 * 33]); o.z = pk2(s[4 * 33], s[5 * 33]); o.w = pk2(s[6 * 33], s[7 * 33]);
        *(u32x4*)(WT + (size_t)(nd0 + n) * K + k0 + 8 * c) = o; }
    __builtin_amdgcn_wave_barrier(); asm volatile("s_waitcnt lgkmcnt(0)" ::: "memory");
}
__device__ __forceinline__ void ln_row(const float* src, const float* g, const float* bb, float* dstf, bf16_t* dstb, int lane) {
    const f32x4* xr = (const f32x4*)src + lane;
    f32x4 v[4]; float s = 0.f;
#pragma unroll
    for (int j = 0; j < 4; ++j) { v[j] = xr[64 * j]; s += (v[j].x + v[j].y) + (v[j].z + v[j].w); }
    const float mean = wave_sum(s, lane) * (1.f / D); float s2 = 0.f;
#pragma unroll
    for (int j = 0; j < 4; ++j) { v[j] = v[j] - mean; s2 += (v[j].x * v[j].x + v[j].y * v[j].y) + (v[j].z * v[j].z + v[j].w * v[j].w); }
    const float rstd = __builtin_amdgcn_rsqf(wave_sum(s2, lane) * (1.f / D) + LN_EPS);
#pragma unroll
    for (int j = 0; j < 4; ++j) {
        const f32x4 gv = ((const f32x4*)g)[lane + 64 * j], bv = ((const f32x4*)bb)[lane + 64 * j];
        const f32x4 o = v[j] * rstd * gv + bv;
        ((f32x4*)dstf)[lane + 64 * j] = o;
        u32x2 w; w.x = pk2(o.x, o.y); w.y = pk2(o.z, o.w);
        ((u32x2*)dstb)[lane + 64 * j] = w;
    }
}

__device__ __forceinline__ void phase_prologue(CArgs& a, unsigned char* ldsg) {
    const int tid = otid(), lane = tid & 63, wave = tid >> 6;
    lfloat* scr = (lfloat*)(MK_LAS unsigned char*)ldsg + wave * 4096;
    const int gw = obid() * 8 + wave, NGW = gridDim.x * 8;
    constexpr int I_IN = 16 * (NU / 32), I_OUT = 16 * 32, I_GLU = 4 * 8;
    constexpr int NITEMS = 4 * (I_IN + I_OUT + I_GLU);
    bf16_t* wtin = (bf16_t*)(a.ws + WS_WTIN); bf16_t* wtout = (bf16_t*)(a.ws + WS_WTOUT); bf16_t* wtglu = (bf16_t*)(a.ws + WS_WTGLU);
    for (int it = gw; it < NITEMS; it += NGW) {
        int r = it;
        if (r < 4 * I_IN) { const int l = r / I_IN; r -= l * I_IN; const int kb = r / (NU / 32), nb = r % (NU / 32); const int nd0 = nb * 32; const int ns0 = nd0 + (nd0 >= 768 ? 4 : 0) + (nd0 >= 2304 ? 8 : 0);
            transpose_item(a.in[I_WIN] + (size_t)l * 1024 * D_IN, D_IN, 1024, kb * 64, ns0, wtin + (size_t)l * NU_PAD * 1024, nd0, scr, lane); continue; }
        r -= 4 * I_IN;
        if (r < 4 * I_OUT) { const int l = r / I_OUT; r -= l * I_OUT; const int kb = r / 32, nb = r % 32;
            transpose_item(a.in[I_WOUT] + (size_t)l * 1024 * 1024, 1024, 1024, kb * 64, nb * 32, wtout + (size_t)l * 1024 * 1024, nb * 32, scr, lane); continue; }
        r -= 4 * I_OUT;
        { const int l = r / I_GLU; r -= l * I_GLU; const int kb = r / 8, nb = r % 8;
            transpose_item(a.in[I_GLUW] + (size_t)l * 256 * 256, 256, 256, kb * 64, nb * 32, wtglu + (size_t)l * 256 * 256, nb * 32, scr, lane); }
    }
    for (int idx = obid() * 512 + tid; idx < 4 * 12 * 1024; idx += gridDim.x * 512) {
        const int l = idx / (12 * 1024), r = idx % (12 * 1024), j = r >> 10, k = r & 1023; const int sc = j < 4 ? 768 + j : 2308 + (j - 4);
        wtin[((size_t)l * NU_PAD + NU + j) * 1024 + k] = f2bf(a.in[I_WIN][((size_t)l * 1024 + k) * D_IN + sc]);
    }
    bf16_t* xb = (bf16_t*)(a.ws + WS_XB);
    for (int row = gw; row < M_REAL; row += NGW) {
        const float* src = row < ROW_SAMPLE ? a.in[I_XP] + (size_t)row * D : (row < ROW_META ? a.in[I_XS] + (size_t)(row - ROW_SAMPLE) * D : a.in[I_META] + (size_t)((row - ROW_META) & 15) * D);
        ln_row(src, a.in[I_LNIG], a.in[I_LNIB], xrow_ptr(a, row), xb + (size_t)row * D, lane);
    }
}
__device__ __forceinline__ void ln_row2(const float* src0, const float* src1, const float* g, const float* bb, float* d0, float* d1, bf16_t* b0, bf16_t* b1, int lane, const bool write_b = true) {
    const f32x4* x0 = (const f32x4*)src0 + lane; const f32x4* x1 = (const f32x4*)src1 + lane;
    f32x4 v0[4], v1[4]; float s0 = 0.f, s1 = 0.f;
#pragma unroll
    for (int j = 0; j < 4; ++j) { v0[j] = x0[64 * j]; v1[j] = x1[64 * j]; }
#pragma unroll
    for (int j = 0; j < 4; ++j) { s0 += (v0[j].x + v0[j].y) + (v0[j].z + v0[j].w); s1 += (v1[j].x + v1[j].y) + (v1[j].z + v1[j].w); }
#pragma unroll
    for (int o = 1; o < 64; o <<= 1) { s0 += __builtin_bit_cast(float, __builtin_amdgcn_ds_bpermute((lane ^ o) << 2, __builtin_bit_cast(int, s0))); s1 += __builtin_bit_cast(float, __builtin_amdgcn_ds_bpermute((lane ^ o) << 2, __builtin_bit_cast(int, s1))); }
    const float m0 = s0 * (1.f / D), m1 = s1 * (1.f / D); float q0 = 0.f, q1 = 0.f;
#pragma unroll
    for (int j = 0; j < 4; ++j) { v0[j] = v0[j] - m0; v1[j] = v1[j] - m1; q0 += (v0[j].x * v0[j].x + v0[j].y * v0[j].y) + (v0[j].z * v0[j].z + v0[j].w * v0[j].w); q1 += (v1[j].x * v1[j].x + v1[j].y * v1[j].y) + (v1[j].z * v1[j].z + v1[j].w * v1[j].w); }
#pragma unroll
    for (int o = 1; o < 64; o <<= 1) { q0 += __builtin_bit_cast(float, __builtin_amdgcn_ds_bpermute((lane ^ o) << 2, __builtin_bit_cast(int, q0))); q1 += __builtin_bit_cast(float, __builtin_amdgcn_ds_bpermute((lane ^ o) << 2, __builtin_bit_cast(int, q1))); }
    const float r0 = __builtin_amdgcn_rsqf(q0 * (1.f / D) + LN_EPS), r1 = __builtin_amdgcn_rsqf(q1 * (1.f / D) + LN_EPS);
#pragma unroll
    for (int j = 0; j < 4; ++j) {
        const f32x4 gv = ((const f32x4*)g)[lane + 64 * j], bv = ((const f32x4*)bb)[lane + 64 * j];
        const f32x4 o0 = v0[j] * r0 * gv + bv, o1 = v1[j] * r1 * gv + bv;
        if (write_b) { ((f32x4*)d0)[lane + 64 * j] = o0; ((f32x4*)d1)[lane + 64 * j] = o1; }
        else { __builtin_nontemporal_store(o0, (f32x4*)d0 + lane + 64 * j); __builtin_nontemporal_store(o1, (f32x4*)d1 + lane + 64 * j); }
        u32x2 w0, w1; w0.x = pk2(o0.x, o0.y); w0.y = pk2(o0.z, o0.w); w1.x = pk2(o1.x, o1.y); w1.y = pk2(o1.z, o1.w);
        if (write_b) { ((u32x2*)b0)[lane + 64 * j] = w0; ((u32x2*)b1)[lane + 64 * j] = w1; }
    }
}
__device__ __forceinline__ void phase_ln(CArgs& a, int l) {
    const int lane = otid() & 63, wave = otid() >> 6, bid = obid();
    bf16_t* xb = (bf16_t*)(a.ws + WS_XB);
    const float* g = a.in[I_LNG] + l * D; const float* bb = a.in[I_LNB] + l * D;
    if (gridDim.x == 256) {
        const int x = bid & 7, wx = (bid >> 3) * 8 + wave;
        for (int p = wx; p < 1024; p += 256) { const int row = 2048 * x + 2 * p; float* x0 = xrow_ptr(a, row); float* x1 = xrow_ptr(a, row + 1);
            ln_row2(x0, x1, g, bb, x0, x1, xb + (size_t)row * D, xb + (size_t)(row + 1) * D, lane, l != DEPTH - 1); }
        const int gw = bid * 8 + wave;
        if (gw < (M_REAL - 16384) / 2) { const int row = 16384 + 2 * gw; float* x0 = xrow_ptr(a, row); float* x1 = xrow_ptr(a, row + 1);
            ln_row2(x0, x1, g, bb, x0, x1, xb + (size_t)row * D, xb + (size_t)(row + 1) * D, lane, l != DEPTH - 1); }
    } else {
        const int gw = bid * 8 + wave, NGW = gridDim.x * 8;
        for (int row = gw * 2; row < M_REAL; row += NGW * 2) { float* x0 = xrow_ptr(a, row); float* x1 = xrow_ptr(a, row + 1);
            ln_row2(x0, x1, g, bb, x0, x1, xb + (size_t)row * D, xb + (size_t)(row + 1) * D, lane, l != DEPTH - 1); }
    }
}

struct EpiU {
    static constexpr bool PERM = true, AFTER_DRAIN = false;
    bf16_t* U; float* USM;
    __device__ __forceinline__ void operator()(const f32x4 (&acc)[2][2][4][2], const Unit& u, int wr_, int wc_, int fr_, int fq_) const {
        const int tid = otid(), lane = tid & 63, wid = __builtin_amdgcn_readfirstlane(tid >> 6), wr = wid >> 2, wc = wid & 3, fr = lane & 15, fq = lane >> 4;
        const int row0 = u.pm * 256 + wr * 64 + fr;
        if (u.pn < 13) {
            const int col0 = u.pn * 256 + wc * 32 + 8 * fq;
#pragma unroll
            for (int ai = 0; ai < 2; ++ai)
#pragma unroll
                for (int m = 0; m < 4; ++m) { bf16_t* rowp = U + (size_t)(row0 + ai * 128 + m * 16) * NU + col0;
#pragma unroll
                    for (int bj = 0; bj < 2; ++bj) { const f32x4 v0 = acc[ai][bj][m][0], v1 = acc[ai][bj][m][1];
                        u32x4 w; w.x = cvt_pk_bf16(v0[0], v0[1]); w.y = cvt_pk_bf16(v0[2], v0[3]); w.z = cvt_pk_bf16(v1[0], v1[1]); w.w = cvt_pk_bf16(v1[2], v1[3]);
                        *(u32x4*)(rowp + bj * 128) = w; }
                    asm volatile("" ::: "memory"); }
        } else if (wc == 0 && fq < 2) {
#pragma unroll
            for (int ai = 0; ai < 2; ++ai)
#pragma unroll
                for (int m = 0; m < 4; ++m) { float* rowp = USM + (size_t)(row0 + ai * 128 + m * 16) * 16 + 8 * fq;
                    *(f32x4*)(rowp) = acc[ai][0][m][0]; *(f32x4*)(rowp + 4) = acc[ai][0][m][1]; }
        }
    }
};
struct EpiGlu {
    static constexpr bool PERM = true, AFTER_DRAIN = false;
    const bf16_t* Y5; const bf16_t* U; const float* bias; bf16_t* MIX;
    __device__ __forceinline__ void operator()(const f32x4 (&acc)[2][2][4][2], const Unit& u, int wr_, int wc_, int fr_, int fq_) const {
        const int tid = otid(), lane = tid & 63, wid = __builtin_amdgcn_readfirstlane(tid >> 6), wr = wid >> 2, wc = wid & 3, fr = lane & 15, fq = lane >> 4;
        const int row0 = u.pm * 256 + wr * 64 + fr, col0 = wc * 32 + 8 * fq;
#pragma unroll
        for (int ai = 0; ai < 2; ++ai)
#pragma unroll
            for (int m = 0; m < 4; ++m) { const size_t row = (size_t)(row0 + ai * 128 + m * 16);
                u32x4 yv[2], zv[2];
#pragma unroll
                for (int bj = 0; bj < 2; ++bj) { const int col = col0 + bj * 128; yv[bj] = *(const u32x4*)(Y5 + row * 256 + col); zv[bj] = *(const u32x4*)(U + row * NU + UC_ZB + col); }
#pragma unroll
                for (int bj = 0; bj < 2; ++bj) { const int col = col0 + bj * 128;
                    const f32x4 b0 = *(const f32x4*)(bias + col), b1 = *(const f32x4*)(bias + col + 4);
                    float o[8];
#pragma unroll
                    for (int j = 0; j < 8; ++j) { const float g = (j < 4 ? acc[ai][bj][m][0][j & 3] : acc[ai][bj][m][1][j & 3]) + (j < 4 ? b0[j & 3] : b1[j & 3]);
                        const unsigned yw = yv[bj][j >> 1], zw = zv[bj][j >> 1];
                        const float y = __uint_as_float((j & 1) ? (yw & 0xffff0000u) : (yw << 16)), z = __uint_as_float((j & 1) ? (zw & 0xffff0000u) : (zw << 16));
                        o[j] = y * sigm(g) * silu(z); }
                    u32x4 w; w.x = pk2(o[0], o[1]); w.y = pk2(o[2], o[3]); w.z = pk2(o[4], o[5]); w.w = pk2(o[6], o[7]);
                    *(u32x4*)(MIX + row * 1024 + 256 + col) = w; }
                asm volatile("" ::: "memory"); }
    }
};
struct EpiOut {
    static constexpr bool PERM = false, AFTER_DRAIN = false;
    float* out; float* xmeta;
    __device__ __forceinline__ void operator()(const f32x4 (&acc)[2][2][4][2], const Unit& u, int wr_, int wc_, int fr_, int fq_) const {
        const int tid = otid(), lane = tid & 63, wid = __builtin_amdgcn_readfirstlane(tid >> 6), wr = wid >> 2, wc = wid & 3, fr = lane & 15, fq = lane >> 4;
        const int row0 = u.pm * 256 + wr * 64 + fr, col0 = u.pn * 256 + wc * 32 + 4 * fq;
#pragma unroll
        for (int ai = 0; ai < 2; ++ai) { const int mb = 0;
            f32x4 xv[4][2][2];
#pragma unroll
            for (int m = mb; m < mb + 4; ++m) { const int row = row0 + ai * 128 + m * 16;
                if (row < M_REAL) { const float* rowp = (row < ROW_META ? out + (size_t)row * D : xmeta + (size_t)(row - ROW_META) * D) + col0;
#pragma unroll
                    for (int bj = 0; bj < 2; ++bj)
#pragma unroll
                        for (int n = 0; n < 2; ++n) xv[m][bj][n] = *(const f32x4*)(rowp + bj * 128 + n * 16); } }
#pragma unroll
            for (int m = mb; m < mb + 4; ++m) { const int row = row0 + ai * 128 + m * 16;
                if (row < M_REAL) { float* rowp = (row < ROW_META ? out + (size_t)row * D : xmeta + (size_t)(row - ROW_META) * D) + col0;
#pragma unroll
                    for (int bj = 0; bj < 2; ++bj)
#pragma unroll
                        for (int n = 0; n < 2; ++n) *(f32x4*)(rowp + bj * 128 + n * 16) = xv[m][bj][n] * DN_ALPHA + acc[ai][bj][m][n]; } }
            asm volatile("" ::: "memory");
        }
    }
};

typedef MK_LAS f32x2 lf32x2;
template <int BR, int MODE>
__device__ __forceinline__ void rec_task(CArgs& a, unsigned char* ldsg, const int l, const bool sample, const int b, const int hp, const int c) {
    const int tid = otid(), hf = __builtin_amdgcn_readfirstlane(tid >> 8), tl = tid & 255, vp = tl >> 3, kq = tl & 7, h = hp * 2 + hf;
    MK_LAS unsigned char* lds = (MK_LAS unsigned char*)ldsg + hf * H_STRIDE;
    MK_LAS bf16_t* RAW = (MK_LAS bf16_t*)(lds + H_RAW); lfloat* ACT = (lfloat*)(lds + H_ACT); lfloat* OBUF = (lfloat*)(lds + H_OBUF); lfloat* SCAL = (lfloat*)(lds + H_SCAL);
    lfloat* MISC = (lfloat*)(lds + H_MISC); lfloat* CWL = (lfloat*)(lds + H_CWL); lfloat* SBUF = (lfloat*)(lds + H_RAW); lfloat* SBUF2 = SBUF + 4160; MK_LAS bf16_t* ZB = (MK_LAS bf16_t*)(lds + H_ZB);
    const bf16_t* U = (const bf16_t*)(a.ws + WS_U); const float* USM = (const float*)(a.ws + WS_USM); bf16_t* MIX = (bf16_t*)(a.ws + WS_XB);
    MK_OPQ(U); MK_OPQ(USM); MK_OPQ(MIX);
    const int nsteps = sample ? TS : CL, t0 = sample ? 0 : c * CL, bh = b * 4 + h, grp = h >> 1;
    const int NC = BR == 0 ? 512 : 768;
    const float* cw = BR == 0 ? a.in[I_SCW] + l * 4 * 512 : a.in[I_GCW] + l * 4 * 768;
    const float* cbias = BR == 0 ? a.in[I_SCB] + l * 512 : a.in[I_GCB] + l * 768;
    const float* cstate = BR == 0 ? a.in[I_SSSDC] + (size_t)(l * 128 + b) * 3 * 512 : a.in[I_SGDNC] + (size_t)(l * 128 + b) * 3 * 768;
    const int uc0 = BR == 0 ? UC_XBC + h * 64 : UC_QKV + h * 64, uc1 = BR == 0 ? UC_XBC + 256 + grp * 64 : UC_QKV + 256 + h * 64, uc2 = BR == 0 ? UC_XBC + 384 + grp * 64 : UC_QKV + 512 + h * 64;
    const int zcol = (BR == 0 ? UC_ZA : (BR == 1 ? UC_ZC : UC_ZD)) + h * 64, mixcol = (BR == 0 ? 0 : (BR == 1 ? 512 : 768)) + h * 64;
    const float* gnp = (BR == 0 ? a.in[I_SNG] : (BR == 1 ? a.in[I_GNG] : a.in[I_HNG])) + (l * 4 + h) * 64;
    const float Dh = BR == 0 ? a.in[I_SD][l * 4 + h] : 0.f;
    float* sloc = (float*)(a.ws + (BR == 0 ? WS_SS : (BR == 1 ? WS_SG : WS_SH))) + (size_t)(bh * NCH + c) * 4096;
    MK_OPQ(sloc);

    lds_barrier();
    if (BR == 2) { if (tl < 64) { const int ch = h * 64 + tl; float p[4], mx = -1e30f, sum = 0.f;
#pragma unroll
            for (int i = 0; i < 4; ++i) { p[i] = a.in[I_HLB][i * 256 + ch]; mx = fmaxf(mx, p[i]); }
#pragma unroll
            for (int i = 0; i < 4; ++i) { p[i] = __expf(p[i] - mx); sum += p[i]; }
            float lb = 0.f;
#pragma unroll
            for (int i = 1; i < 4; ++i) if (i <= l) lb += p[i];
            MISC[tl] = lb * __builtin_amdgcn_rcpf(sum); } }
    else { for (int idx = tl; idx < 5 * 192; idx += 256) { const int w = idx / 192, ch = idx - w * 192, part = ch >> 6, d = ch & 63; const int ci = (part == 0 ? uc0 : (part == 1 ? uc1 : uc2)) - (BR == 0 ? UC_XBC : UC_QKV) + d;
            CWL[idx] = w < 4 ? cw[w * NC + ci] : cbias[ci]; } }
    f32x2 S[8], T[8]; float zero_ = 0.f, one_ = 1.f; asm volatile("" : "+v"(zero_), "+v"(one_));
    if (MODE == 1) {
        const float* s_in = sample ? (BR == 0 ? a.in[I_SSSD] : (BR == 1 ? a.in[I_SGDN] : a.in[I_SHG])) + (size_t)((l * 128 + b) * 4 + h) * 4096 : sloc;
        { float tmp[16];
#pragma unroll
          for (int i = 0; i < 16; ++i) tmp[i] = sample ? __builtin_nontemporal_load(s_in + tl + i * 256) : s_in[tl + i * 256];
#pragma unroll
          for (int i = 0; i < 16; ++i) { const int idx = tl + i * 256; SBUF[(idx >> 6) * 65 + (idx & 63)] = tmp[i]; } }
        lds_barrier();
#pragma unroll
        for (int i = 0; i < 8; ++i) { S[i][0] = SBUF[(kq * 8 + i) * 65 + 2 * vp]; S[i][1] = SBUF[(kq * 8 + i) * 65 + 2 * vp + 1]; }
    } else {
#pragma unroll
        for (int i = 0; i < 8; ++i) { S[i][0] = zero_; S[i][1] = zero_;
            T[i][0] = (BR == 1) ? ((kq * 8 + i == 2 * vp) ? one_ : zero_) : one_; T[i][1] = (BR == 1) ? ((kq * 8 + i == 2 * vp + 1) ? one_ : zero_) : one_; }
    }
    float decprod = one_, tprod = one_;
    f32x4 lacc[4] = {{zero_, zero_, zero_, zero_}, {zero_, zero_, zero_, zero_}, {zero_, zero_, zero_, zero_}, {zero_, zero_, zero_, zero_}};

    for (int ts = 0; ts < nsteps; ts += ST) {
        const int n = (nsteps - ts) < ST ? (nsteps - ts) : ST;
        lds_barrier();
        if (BR == 2) {
            u32x4 ld[6];
#pragma unroll
            for (int it = 0; it < 6; ++it) { const int idx = tl + it * 256; const int s = idx >> 5, part = (idx >> 3) & 3, oct = idx & 7; ld[it] = (u32x4){0u, 0u, 0u, 0u};
                if (s < n && !(MODE == 0 && (part & 1))) { const int t = t0 + ts + s; const int row = sample ? ROW_SAMPLE + b * 4 + t : prow(b, t);
                    const int col = (part == 0 ? UC_FD : (part == 1 ? UC_QD : (part == 2 ? UC_ID : UC_ZD))) + h * 64 + oct * 8;
                    ld[it] = *(const u32x4*)(U + (size_t)row * NU + col); } }
#pragma unroll
            for (int it = 0; it < 6; ++it) { const int idx = tl + it * 256; const int s = idx >> 5, part = (idx >> 3) & 3, oct = idx & 7;
                if (s < n && !(MODE == 0 && (part & 1))) { float x[8];
#pragma unroll
                    for (int j = 0; j < 4; ++j) { x[2 * j] = __uint_as_float(ld[it][j] << 16); x[2 * j + 1] = __uint_as_float(ld[it][j] & 0xffff0000u); }
                    if (part == 0) {
#pragma unroll
                        for (int j = 0; j < 8; ++j) { const float lb = MISC[oct * 8 + j]; x[j] = lb + (1.f - lb) * sigm(x[j]); } }
                    else if (part == 1) {
#pragma unroll
                        for (int j = 0; j < 8; ++j) x[j] = silu(x[j]); }
                    if (part == 3) *(MK_LAS u32x4*)(ZB + s * 64 + oct * 8) = ld[it];
                    else { lfloat* dst = ACT + s * 256 + part * 64 + oct * 8; *(lf32x4*)dst = (f32x4){x[0], x[1], x[2], x[3]}; *(lf32x4*)(dst + 4) = (f32x4){x[4], x[5], x[6], x[7]}; } } }
            lds_barrier();
        } else {
            u32x4 ld[6]; f32x4 lf0[6], lf1[6];
#pragma unroll
            for (int it = 0; it < 6; ++it) { const int idx = tl + it * 256; const int j = idx >> 5, part = (idx >> 3) & 3, oct = idx & 7, t = t0 + ts - 3 + j;
                ld[it] = (u32x4){0u, 0u, 0u, 0u}; lf0[it] = (f32x4){0.f, 0.f, 0.f, 0.f}; lf1[it] = lf0[it];
                if (j < n + 3 && !(MODE == 0 && (part == 3 || part == (BR == 0 ? 2 : 0)))) { const int ucb = part == 0 ? uc0 : (part == 1 ? uc1 : (part == 2 ? uc2 : zcol));
                    if (t >= 0) { if (part < 3 || j >= 3) { const int row = sample ? ROW_SAMPLE + b * 4 + t : prow(b, t); ld[it] = *(const u32x4*)(U + (size_t)row * NU + ucb + oct * 8); } }
                    else if (sample && part < 3) { const float* cp = cstate + (3 + t) * NC + ucb - (BR == 0 ? UC_XBC : UC_QKV) + oct * 8; lf0[it] = *(const f32x4*)cp; lf1[it] = *(const f32x4*)(cp + 4); } } }
            if (tl < n) { const int t = t0 + ts + tl; const int row = sample ? ROW_SAMPLE + b * 4 + t : prow(b, t);
                if (BR == 0) { const float dtv = softplus(USM[(size_t)row * 16 + h] + a.in[I_SDTB][l * 4 + h]); const float aa = -dtv * __expf(a.in[I_SALOG][l * 4 + h]); SCAL[tl * 2] = __expf(aa); SCAL[tl * 2 + 1] = dtv; }
                else { const float beta = sigm(USM[(size_t)row * 16 + 4 + h]); const float g = -__expf(a.in[I_GALOG][l * 4 + h]) * softplus(USM[(size_t)row * 16 + 8 + h] + a.in[I_GDTB][l * 4 + h]); SCAL[tl * 2] = __expf(g); SCAL[tl * 2 + 1] = beta; } }
#pragma unroll
            for (int it = 0; it < 6; ++it) { const int idx = tl + it * 256; const int j = idx >> 5, part = (idx >> 3) & 3, oct = idx & 7, t = t0 + ts - 3 + j;
                if (j < n + 3 && (part < 3 || j >= 3) && !(MODE == 0 && (part == 3 || part == (BR == 0 ? 2 : 0)))) { u32x4 rw = ld[it];
                    if (t < 0) { rw.x = pk2(lf0[it][0], lf0[it][1]); rw.y = pk2(lf0[it][2], lf0[it][3]); rw.z = pk2(lf1[it][0], lf1[it][1]); rw.w = pk2(lf1[it][2], lf1[it][3]); }
                    if (part == 3) *(MK_LAS u32x4*)(ZB + (j - 3) * 64 + oct * 8) = rw; else *(MK_LAS u32x4*)(RAW + j * 192 + part * 64 + oct * 8) = rw; } }
            lds_barrier();
            constexpr int NCG = (MODE == 0) ? 32 : 48, CH0 = (MODE == 0 && BR == 1) ? 64 : 0;
            for (int idx = tl; idx < n * NCG; idx += 256) { const int s = idx / NCG, ch = CH0 + (idx - s * NCG) * 4, part = ch >> 6, d = ch & 63;
                f32x4 acc = *(const lf32x4*)(CWL + 4 * 192 + ch);
#pragma unroll
                for (int w = 0; w < 4; ++w) { const u32x2 rv = *(const MK_LAS u32x2*)(RAW + (s + w) * 192 + ch);
                    acc += *(const lf32x4*)(CWL + w * 192 + ch) * (f32x4){__uint_as_float(rv.x << 16), __uint_as_float(rv.x & 0xffff0000u), __uint_as_float(rv.y << 16), __uint_as_float(rv.y & 0xffff0000u)}; }
                acc = (f32x4){silu(acc[0]), silu(acc[1]), silu(acc[2]), silu(acc[3])};
                if (BR == 0) { if (part == 0) { *(lf32x4*)(ACT + s * 256 + 192 + d) = acc; *(lf32x4*)(ACT + s * 256 + 128 + d) = acc * SCAL[s * 2 + 1]; } else if (part == 1) *(lf32x4*)(ACT + s * 256 + d) = acc; else *(lf32x4*)(ACT + s * 256 + 64 + d) = acc; }
                else { if (part == 0) *(lf32x4*)(ACT + s * 256 + 64 + d) = acc; else if (part == 1) *(lf32x4*)(ACT + s * 256 + d) = acc; else *(lf32x4*)(ACT + s * 256 + 128 + d) = acc; } }
            lds_barrier();
            if (BR == 1) {
#pragma unroll
                for (int pass = 0; pass < 3; ++pass) { const int r = pass * 32 + vp;
                    if (r < (MODE == 0 ? n : 2 * n)) { const int s = MODE == 0 ? r : (r >> 1), isq = MODE == 0 ? 0 : (r & 1); lfloat* p = ACT + s * 256 + (isq ? 64 : 0) + kq * 8; const f32x4 x0 = *(lf32x4*)p, x1 = *(lf32x4*)(p + 4);
                        float ss = (x0[0] * x0[0] + x0[1] * x0[1]) + (x0[2] * x0[2] + x0[3] * x0[3]) + (x1[0] * x1[0] + x1[1] * x1[1]) + (x1[2] * x1[2] + x1[3] * x1[3]);
                        ss = red8(ss); const float sc = __builtin_amdgcn_rsqf(ss + L2_EPS) * (isq ? 0.125f : 1.f);
                        *(lf32x4*)p = x0 * sc; *(lf32x4*)(p + 4) = x1 * sc; }
                    else { (void)red8(0.f); } }
                lds_barrier(); }
        }
        if (MODE == 0 && BR != 1) {
            const int lane = tid & 63, kt = (tl >> 6), n4 = (n + 3) & ~3;
            if (BR == 0) { if (tl == 0) { float dv[ST];
#pragma unroll
                    for (int s = 0; s < ST; ++s) dv[s] = s < n ? SCAL[s * 2] : one_;
                    float run = one_;
#pragma unroll
                    for (int s = ST - 1; s >= 0; --s) { if (s < n) SCAL[s * 2 + 1] = run; run *= dv[s]; }
                    SCAL[2 * ST] = run; } }
            else { if (tl < 64) { float fv[ST];
#pragma unroll
                    for (int s = 0; s < ST; ++s) fv[s] = s < n ? ACT[s * 256 + tl] : one_;
                    float run = one_;
#pragma unroll
                    for (int s = ST - 1; s >= 0; --s) { if (s < n) ACT[s * 256 + tl] = (1.f - fv[s]) * run; run *= fv[s]; }
                    CWL[tl] = run; tprod *= run; } }
            for (int idx = tl; idx < (n4 - n) * 64; idx += 256) { const int s = n + (idx >> 6), d = idx & 63; ACT[s * 256 + d] = 0.f; ACT[s * 256 + 128 + d] = 0.f; }
            lds_barrier();
            if (BR == 0) { const float Dt = SCAL[2 * ST]; decprod *= Dt;
#pragma unroll
                for (int vt = 0; vt < 4; ++vt) lacc[vt] = lacc[vt] * Dt; }
            else {
#pragma unroll
                for (int r = 0; r < 4; ++r) { const float dk = CWL[kt * 16 + 4 * (lane >> 4) + r];
#pragma unroll
                    for (int vt = 0; vt < 4; ++vt) lacc[vt][r] *= dk; } }
            for (int s0 = 0; s0 < n4; s0 += 4) { const int sr = s0 + (lane >> 4); const lfloat* rp = ACT + sr * 256 + (lane & 15); float av = rp[kt * 16];
                if (BR == 0) av *= (sr < n ? SCAL[sr * 2 + 1] : 0.f);
#pragma unroll
                for (int vt = 0; vt < 4; ++vt) lacc[vt] = __builtin_amdgcn_mfma_f32_16x16x4f32(av, rp[128 + vt * 16], lacc[vt], 0, 0, 0); }
        } else
#define REC_BODY(a0, a1, b0, b1, vv, sc0, sc1, s) do { \
    const float A[8] = {a0[0], a0[1], a0[2], a0[3], a1[0], a1[1], a1[2], a1[3]}; \
    const float Bq[8] = {b0[0], b0[1], b0[2], b0[3], b1[0], b1[1], b1[2], b1[3]}; \
    if (BR == 0) { \
    if (MODE == 0) { decprod *= sc0; \
    _Pragma("unroll") \
    for (int i = 0; i < 8; ++i) S[i] = S[i] * sc0 + vv * A[i]; \
    } else { f32x2 ya = {0.f, 0.f}; \
    _Pragma("unroll") \
    for (int i = 0; i < 8; ++i) { S[i] = S[i] * sc0 + vv * A[i]; ya += S[i] * Bq[i]; } \
    f32x2 y; y[0] = red8(ya[0]); y[1] = red8(ya[1]); if (kq == 0) *(lf32x2*)(OBUF + s * 64 + 2 * vp) = y; } \
    } else if (BR == 1) { \
    if (MODE == 0) { f32x2 ra = {0.f, 0.f}, rp = {0.f, 0.f}; \
    _Pragma("unroll") \
    for (int i = 0; i < 8; ++i) { S[i] *= sc0; T[i] *= sc0; ra += S[i] * A[i]; rp += T[i] * A[i]; } \
    f32x2 r, rpp; r[0] = red8(ra[0]); r[1] = red8(ra[1]); rpp[0] = red8(rp[0]); rpp[1] = red8(rp[1]); \
    const f32x2 vn = (vv - r) * sc1, vnp = rpp * (-sc1); \
    _Pragma("unroll") \
    for (int i = 0; i < 8; ++i) { S[i] += vn * A[i]; T[i] += vnp * A[i]; } \
    } else { f32x2 ra = {0.f, 0.f}; \
    _Pragma("unroll") \
    for (int i = 0; i < 8; ++i) { S[i] *= sc0; ra += S[i] * A[i]; } \
    f32x2 r; r[0] = red8(ra[0]); r[1] = red8(ra[1]); \
    const f32x2 vn = (vv - r) * sc1; f32x2 oa = {0.f, 0.f}; \
    _Pragma("unroll") \
    for (int i = 0; i < 8; ++i) { S[i] += vn * A[i]; oa += S[i] * Bq[i]; } \
    f32x2 o; o[0] = red8(oa[0]); o[1] = red8(oa[1]); if (kq == 0) *(lf32x2*)(OBUF + s * 64 + 2 * vp) = o; } \
    } else { \
    if (MODE == 0) { \
    _Pragma("unroll") \
    for (int i = 0; i < 8; ++i) { S[i] = S[i] * A[i] + vv * (1.f - A[i]); T[i] *= A[i]; } \
    } else { f32x2 oa = {0.f, 0.f}; \
    _Pragma("unroll") \
    for (int i = 0; i < 8; ++i) { S[i] = S[i] * A[i] + vv * (1.f - A[i]); oa += S[i] * Bq[i]; } \
    f32x2 o; o[0] = red8(oa[0]); o[1] = red8(oa[1]); if (kq == 0) *(lf32x2*)(OBUF + s * 64 + 2 * vp) = o; } \
    } \
    } while (0)
#define REC_FETCH(a0, a1, b0, b1, vv, sc0, sc1, SI) do { const int si_ = (SI); const lfloat* an_ = ACT + si_ * 256 + kq * 8; \
    a0 = *(const lf32x4*)(an_); a1 = *(const lf32x4*)(an_ + 4); if (MODE == 1) { b0 = *(const lf32x4*)(an_ + 64); b1 = *(const lf32x4*)(an_ + 68); } \
    vv = *(const lf32x2*)(ACT + si_ * 256 + 128 + 2 * vp); sc0 = (BR != 2) ? SCAL[si_ * 2] : 0.f; sc1 = (BR == 1) ? SCAL[si_ * 2 + 1] : 0.f; } while (0)
        if (MODE == 0)
        {
            const lfloat* ar = ACT + kq * 8;
            f32x4 a0 = *(const lf32x4*)(ar), a1 = *(const lf32x4*)(ar + 4), b0 = *(const lf32x4*)(ar + 64), b1 = *(const lf32x4*)(ar + 68);
            f32x2 vv = *(const lf32x2*)(ACT + 128 + 2 * vp); float sc0 = (BR != 2) ? SCAL[0] : 0.f, sc1 = (BR == 1) ? SCAL[1] : 0.f;
#pragma unroll 2
            for (int s = 0; s < n; ++s) {
                const int sn = (s + 1 < n) ? s + 1 : s;
                const lfloat* an = ACT + sn * 256 + kq * 8;
                const f32x4 na0 = *(const lf32x4*)(an), na1 = *(const lf32x4*)(an + 4);
                f32x4 nb0 = b0, nb1 = b1;
                if (MODE == 1) { nb0 = *(const lf32x4*)(an + 64); nb1 = *(const lf32x4*)(an + 68); }
                const f32x2 nvv = *(const lf32x2*)(ACT + sn * 256 + 128 + 2 * vp); const float nsc0 = (BR != 2) ? SCAL[sn * 2] : 0.f, nsc1 = (BR == 1) ? SCAL[sn * 2 + 1] : 0.f;
                const float A[8] = {a0[0], a0[1], a0[2], a0[3], a1[0], a1[1], a1[2], a1[3]};
                const float Bq[8] = {b0[0], b0[1], b0[2], b0[3], b1[0], b1[1], b1[2], b1[3]};
                if (BR == 0) {
                    if (MODE == 0) { decprod *= sc0;
#pragma unroll
                        for (int i = 0; i < 8; ++i) S[i] = S[i] * sc0 + vv * A[i];
                    } else { f32x2 ya = {0.f, 0.f};
#pragma unroll
                        for (int i = 0; i < 8; ++i) { S[i] = S[i] * sc0 + vv * A[i]; ya += S[i] * Bq[i]; }
                        f32x2 y; y[0] = red8(ya[0]); y[1] = red8(ya[1]); if (kq == 0) *(lf32x2*)(OBUF + s * 64 + 2 * vp) = y; }
                } else if (BR == 1) {
                    if (MODE == 0) { f32x2 ra = {0.f, 0.f}, rp = {0.f, 0.f};
#pragma unroll
                        for (int i = 0; i < 8; ++i) { S[i] *= sc0; T[i] *= sc0; ra += S[i] * A[i]; rp += T[i] * A[i]; }
                        f32x2 r, rpp; r[0] = red8(ra[0]); r[1] = red8(ra[1]); rpp[0] = red8(rp[0]); rpp[1] = red8(rp[1]);
                        const f32x2 vn = (vv - r) * sc1, vnp = rpp * (-sc1);
#pragma unroll
                        for (int i = 0; i < 8; ++i) { S[i] += vn * A[i]; T[i] += vnp * A[i]; }
                    } else { f32x2 ra = {0.f, 0.f};
#pragma unroll
                        for (int i = 0; i < 8; ++i) { S[i] *= sc0; ra += S[i] * A[i]; }
                        f32x2 r; r[0] = red8(ra[0]); r[1] = red8(ra[1]);
                        const f32x2 vn = (vv - r) * sc1; f32x2 oa = {0.f, 0.f};
#pragma unroll
                        for (int i = 0; i < 8; ++i) { S[i] += vn * A[i]; oa += S[i] * Bq[i]; }
                        f32x2 o; o[0] = red8(oa[0]); o[1] = red8(oa[1]); if (kq == 0) *(lf32x2*)(OBUF + s * 64 + 2 * vp) = o; }
                } else {
                    if (MODE == 0) {
#pragma unroll
                        for (int i = 0; i < 8; ++i) { S[i] = S[i] * A[i] + vv * (1.f - A[i]); T[i] *= A[i]; }
                    } else { f32x2 oa = {0.f, 0.f};
#pragma unroll
                        for (int i = 0; i < 8; ++i) { S[i] = S[i] * A[i] + vv * (1.f - A[i]); oa += S[i] * Bq[i]; }
                        f32x2 o; o[0] = red8(oa[0]); o[1] = red8(oa[1]); if (kq == 0) *(lf32x2*)(OBUF + s * 64 + 2 * vp) = o; }
                }
                a0 = na0; a1 = na1; b0 = nb0; b1 = nb1; vv = nvv; sc0 = nsc0; sc1 = nsc1;
            }
        }
        else
        {
            f32x4 pa0, pa1, pb0, pb1, qa0, qa1, qb0, qb1; pb0 = pb1 = qb0 = qb1 = pa0 = pa1 = qa0 = qa1 = (f32x4){zero_, zero_, zero_, zero_}; f32x2 pvv, qvv; float psc0, psc1, qsc0, qsc1;
            REC_FETCH(pa0, pa1, pb0, pb1, pvv, psc0, psc1, 0);
#pragma nounroll
            for (int s = 0; s < n; s += 2) {
                REC_FETCH(qa0, qa1, qb0, qb1, qvv, qsc0, qsc1, (s + 1 < n) ? s + 1 : s);
                REC_BODY(pa0, pa1, pb0, pb1, pvv, psc0, psc1, s);
                if (s + 1 < n) {
                    REC_FETCH(pa0, pa1, pb0, pb1, pvv, psc0, psc1, (s + 2 < n) ? s + 2 : s + 1);
                    REC_BODY(qa0, qa1, qb0, qb1, qvv, qsc0, qsc1, (s + 1));
                }
            }
        }
#undef REC_BODY
#undef REC_FETCH
        if (MODE == 1) {
            lds_barrier();
#pragma unroll
            for (int pass = 0; pass < 2; ++pass) {
                const int sidx = pass * 32 + vp; float ss = 0.f; float o[8];
                if (sidx < n) { const f32x4 o0 = *(const lf32x4*)(OBUF + sidx * 64 + kq * 8), o1 = *(const lf32x4*)(OBUF + sidx * 64 + kq * 8 + 4);
                    o[0] = o0[0]; o[1] = o0[1]; o[2] = o0[2]; o[3] = o0[3]; o[4] = o1[0]; o[5] = o1[1]; o[6] = o1[2]; o[7] = o1[3];
                    if (BR == 0) {
#pragma unroll
                        for (int i = 0; i < 8; ++i) o[i] += Dh * ACT[sidx * 256 + 192 + kq * 8 + i]; }
#pragma unroll
                    for (int i = 0; i < 8; ++i) ss += o[i] * o[i]; }
                ss = red8(ss);
                if (sidx < n) { const int t = t0 + ts + sidx; const int row = sample ? ROW_SAMPLE + b * 4 + t : prow(b, t);
                    const float r = __builtin_amdgcn_rsqf(ss * (1.f / 64.f) + RMS_EPS);
                    const f32x4 g0 = *(const f32x4*)(gnp + kq * 8), g1 = *(const f32x4*)(gnp + kq * 8 + 4);
                    const u32x4 zw = *(const MK_LAS u32x4*)(ZB + sidx * 64 + kq * 8);
                    const float z[8] = {__uint_as_float(zw.x << 16), __uint_as_float(zw.x & 0xffff0000u), __uint_as_float(zw.y << 16), __uint_as_float(zw.y & 0xffff0000u),
                                        __uint_as_float(zw.z << 16), __uint_as_float(zw.z & 0xffff0000u), __uint_as_float(zw.w << 16), __uint_as_float(zw.w & 0xffff0000u)};
                    u32x4 w; w.x = pk2(o[0] * r * g0[0] * silu(z[0]), o[1] * r * g0[1] * silu(z[1])); w.y = pk2(o[2] * r * g0[2] * silu(z[2]), o[3] * r * g0[3] * silu(z[3]));
                    w.z = pk2(o[4] * r * g1[0] * silu(z[4]), o[5] * r * g1[1] * silu(z[5])); w.w = pk2(o[6] * r * g1[2] * silu(z[6]), o[7] * r * g1[3] * silu(z[7]));
                    *(u32x4*)(MIX + (size_t)row * 1024 + mixcol + kq * 8) = w; }
            }
        }
    }
    if (MODE == 0 && BR != 1) {
        const int lane = tid & 63, kt = (tl >> 6);
#pragma unroll
        for (int vt = 0; vt < 4; ++vt)
#pragma unroll
            for (int r = 0; r < 4; ++r) sloc[(kt * 16 + 4 * (lane >> 4) + r) * 64 + vt * 16 + (lane & 15)] = lacc[vt][r];
        if (BR == 0 && tl == 0) ((float*)(a.ws + WS_DS))[bh * NCH + c] = decprod;
        if (BR == 2 && tl < 64) ((float*)(a.ws + WS_DH))[(bh * NCH + c) * 64 + tl] = tprod;
    } else
    if (MODE == 0 || sample) {
        float* dst = MODE == 0 ? sloc : a.out + (BR == 0 ? O_SSSD : (BR == 1 ? O_SGDN : O_SHG)) + (size_t)((l * 128 + b) * 4 + h) * 4096;
        lds_barrier();
#pragma unroll
        for (int i = 0; i < 8; ++i) { SBUF[(kq * 8 + i) * 65 + 2 * vp] = S[i][0]; SBUF[(kq * 8 + i) * 65 + 2 * vp + 1] = S[i][1]; }
        if (MODE == 0 && BR == 1) {
#pragma unroll
            for (int i = 0; i < 8; ++i) { SBUF2[(kq * 8 + i) * 65 + 2 * vp] = T[i][0]; SBUF2[(kq * 8 + i) * 65 + 2 * vp + 1] = T[i][1]; } }
        lds_barrier();
        for (int idx = tl; idx < 4096; idx += 256) { const float sv = SBUF[(idx >> 6) * 65 + (idx & 63)]; if (MODE == 1) __builtin_nontemporal_store(sv, dst + idx); else dst[idx] = sv; }
        if (MODE == 0 && BR == 1) { float* pd = (float*)(a.ws + WS_PG) + (size_t)(bh * NCH + c) * 4096; for (int idx = tl; idx < 4096; idx += 256) pd[idx] = SBUF2[(idx >> 6) * 65 + (idx & 63)]; }
        if (MODE == 0 && BR == 0 && tl == 0) ((float*)(a.ws + WS_DS))[bh * NCH + c] = decprod;
        if (MODE == 0 && BR == 2 && vp == 0) {
#pragma unroll
            for (int i = 0; i < 8; ++i) ((float*)(a.ws + WS_DH))[(bh * NCH + c) * 64 + kq * 8 + i] = T[i][0]; }
    }
}

constexpr int L5_CRE = 0, L5_CIM = 4352, L5_UB = 8704, L5_HB = 16896;
static_assert(L5_HB + 8 * 16 * 132 * 4 <= 131072, "lds5");
template <int MODE>
__device__ __forceinline__ void s5_task(CArgs& a, unsigned char* ldsg, const int l, const bool sample, const int g, const int c) {
    MK_LAS unsigned char* lds = (MK_LAS unsigned char*)ldsg;
    lfloat* CRE = (lfloat*)(lds + L5_CRE); lfloat* CIM = (lfloat*)(lds + L5_CIM);
    const int tid = otid(), lane = tid & 63, wave = tid >> 6;
    lfloat* UB = (lfloat*)(lds + L5_UB) + wave * 256; MK_LAS bf16_t* HB = (MK_LAS bf16_t*)(lds + L5_HB) + wave * 16 * 136;
    const bf16_t* U = (const bf16_t*)(a.ws + WS_U); bf16_t* Y5 = (bf16_t*)(a.ws + WS_Y5);
    MK_OPQ(U); MK_OPQ(Y5);
    const int b = sample ? c * 8 + wave : wave, nsteps = sample ? TS : CL, t0 = sample ? 0 : c * CL, lg = l * 16 + g;
    const float dt = __expf(a.in[I_LOGDT][lg]); const float lr = a.in[I_LAMR][lg * 64 + lane], li = a.in[I_LAMI][lg * 64 + lane];
    const float mag = __expf(lr * dt); float sn, cs; { float rv = li * dt * 0.15915494309189535f; rv -= rintf(rv); sn = __builtin_amdgcn_sinf(rv); cs = __builtin_amdgcn_cosf(rv); }
    const float lbr = mag * cs, lbi = mag * sn, den = lr * lr + li * li, nr = lbr - 1.f;
    const float rden = __builtin_amdgcn_rcpf(den); const float cr = (nr * lr + lbi * li) * rden, ci = (lbi * lr - nr * li) * rden;
    float bbr[16], bbi[16];
    { const f32x4* pr = (const f32x4*)(a.in[I_BR] + (size_t)(lg * 64 + lane) * 16); const f32x4* pi = (const f32x4*)(a.in[I_BI] + (size_t)(lg * 64 + lane) * 16);
#pragma unroll
        for (int j = 0; j < 4; ++j) { const f32x4 r = pr[j], im = pi[j];
#pragma unroll
            for (int k = 0; k < 4; ++k) { bbr[j * 4 + k] = cr * r[k] - ci * im[k]; bbi[j * 4 + k] = cr * im[k] + ci * r[k]; } } }
    __syncthreads();
    pg8::bf16x8 cfrag[4];
    if (MODE == 1) {
#pragma unroll
        for (int kb = 0; kb < 4; ++kb)
#pragma unroll
            for (int j = 0; j < 8; ++j) { const int k = (kb & 1) * 32 + (lane >> 4) * 8 + j;
                const float cv = kb < 2 ? a.in[I_CR][(size_t)lg * 1024 + (lane & 15) * 64 + k] : -a.in[I_CI][(size_t)lg * 1024 + (lane & 15) * 64 + k];
                cfrag[kb][j] = (short)f2bf(cv); } }
    float* h5 = (float*)(a.ws + WS_H5) + (size_t)((b * 16 + g) * NCH + c) * 128;
    float hr = 0.f, hi = 0.f;
    if (MODE == 1) { if (sample) { hr = a.in[I_SS5R][(size_t)((l * 128 + b) * 16 + g) * 64 + lane]; hi = a.in[I_SS5I][(size_t)((l * 128 + b) * 16 + g) * 64 + lane]; } else { hr = h5[lane]; hi = h5[64 + lane]; } }
    __syncthreads();
    const int tt = lane >> 2, qq = lane & 3;
    float dq = 0.f;
    if (MODE == 1) dq = a.in[I_S5D][lg * 16 + (lane & 15)];
    for (int ts = 0; ts < nsteps; ts += 16) {
        const int n = (nsteps - ts) < 16 ? (nsteps - ts) : 16;
        { f32x4 uv = {0.f, 0.f, 0.f, 0.f};
          if (tt < n) { const int t = t0 + ts + tt; const int row = sample ? ROW_SAMPLE + b * 4 + t : prow(b, t); const u32x2 w = *(const u32x2*)(U + (size_t)row * NU + UC_UB + g * 16 + qq * 4);
              uv[0] = __uint_as_float(w.x << 16); uv[1] = __uint_as_float(w.x & 0xffff0000u); uv[2] = __uint_as_float(w.y << 16); uv[3] = __uint_as_float(w.y & 0xffff0000u); }
          *(lf32x4*)(UB + tt * 16 + qq * 4) = uv; }
        __builtin_amdgcn_wave_barrier(); asm volatile("s_waitcnt lgkmcnt(0)" ::: "memory");
        for (int s = 0; s < n; ++s) {
            float bur = 0.f, bui = 0.f;
#pragma unroll
            for (int j = 0; j < 4; ++j) { const f32x4 uu = *(const lf32x4*)(UB + s * 16 + j * 4);
#pragma unroll
                for (int k = 0; k < 4; ++k) { bur += bbr[j * 4 + k] * uu[k]; bui += bbi[j * 4 + k] * uu[k]; } }
            const float nhr = lbr * hr - lbi * hi + bur, nhi = lbr * hi + lbi * hr + bui; hr = nhr; hi = nhi;
            if (MODE == 1) { HB[s * 136 + lane] = f2bf(hr); HB[s * 136 + 64 + lane] = f2bf(hi); }
        }
        if (MODE == 1) {
            __builtin_amdgcn_wave_barrier(); asm volatile("s_waitcnt lgkmcnt(0)" ::: "memory");
            {
                f32x4 d = {0.f, 0.f, 0.f, 0.f};
#pragma unroll
                for (int kb = 0; kb < 4; ++kb) { const pg8::bf16x8 af = *(const MK_LAS pg8::bf16x8*)(HB + (lane & 15) * 136 + kb * 32 + (lane >> 4) * 8);
                    d = __builtin_amdgcn_mfma_f32_16x16x32_bf16(af, cfrag[kb], d, 0, 0, 0); }
                const int q = lane & 15;
#pragma unroll
                for (int r = 0; r < 4; ++r) { const int st = 4 * (lane >> 4) + r;
                    if (st < n) { const int t = t0 + ts + st; const int row = sample ? ROW_SAMPLE + b * 4 + t : prow(b, t);
                        Y5[(size_t)row * 256 + g * 16 + q] = f2bf(gelu_tanh(d[r] + dq * UB[st * 16 + q])); } }
            }
            __builtin_amdgcn_wave_barrier(); asm volatile("s_waitcnt lgkmcnt(0)" ::: "memory");
        }
    }
    if (MODE == 0) { h5[lane] = hr; h5[64 + lane] = hi; }
    else if (sample) { a.out[O_SS5R + (size_t)((l * 128 + b) * 16 + g) * 64 + lane] = hr; a.out[O_SS5I + (size_t)((l * 128 + b) * 16 + g) * 64 + lane] = hi; }
}

__device__ __forceinline__ void conv_copy_task(CArgs& a, int l, int part, int nparts) {
    const bf16_t* U = (const bf16_t*)(a.ws + WS_U); MK_OPQ(U);
    const int tid = otid();
    for (int unit = part; unit < 136 * 3; unit += nparts) {
        const int sb = unit / 3, j = unit - sb * 3; const bool smp = sb >= 8; const int b = smp ? sb - 8 : sb;
        const int row = smp ? ROW_SAMPLE + b * 4 + 1 + j : prow(b, TP - 3 + j);
        const bf16_t* ur = U + (size_t)row * NU;
        float* o1 = a.out + (smp ? O_SSSDC + (size_t)(l * 128 + b) * SZ_SC : O_PSSDC + (size_t)(l * 8 + b) * SZ_SC) + j * 512;
        float* o2 = a.out + (smp ? O_SGDNC + (size_t)(l * 128 + b) * SZ_GC : O_PGDNC + (size_t)(l * 8 + b) * SZ_GC) + j * 768;
        MK_OPQ(ur); MK_OPQ(o1); MK_OPQ(o2);
        for (int ch = tid; ch < 1280; ch += 512) { if (ch < 512) o1[ch] = bf2f(ur[UC_XBC + ch]); else o2[ch - 512] = bf2f(ur[UC_QKV + ch - 512]); }
    }
}

__device__ __forceinline__ void pass2_gdn(CArgs& a, unsigned char* ldsg, int l, int bh, int vb) {
    MK_LAS unsigned char* lds = (MK_LAS unsigned char*)ldsg;
    lfloat* PL = (lfloat*)lds; lfloat* SL = (lfloat*)(lds + 64 * 68 * 4);
    const int tid = otid(), k = tid >> 3, vv = tid & 7;
    float* sg = (float*)(a.ws + WS_SG) + (size_t)bh * NCH * 4096; const float* pg = (const float*)(a.ws + WS_PG) + (size_t)bh * NCH * 4096;
    MK_OPQ(sg); MK_OPQ(pg);
    lds_barrier();
    float cur = 0.f; asm volatile("" : "+v"(cur));
    SL[k * 8 + vv] = cur;
    f32x4 p0 = *(const f32x4*)(pg + tid * 8), p1 = *(const f32x4*)(pg + tid * 8 + 4);
    float lval = sg[k * 64 + vb * 8 + vv];
    for (int c = 0; c < NCH; ++c) {
        { const int r = tid >> 3, cc = (tid & 7) * 8; *(lf32x4*)(PL + r * 68 + cc) = p0; *(lf32x4*)(PL + r * 68 + cc + 4) = p1; }
        float* slot = sg + (size_t)c * 4096 + k * 64 + vb * 8 + vv;
        float acc = lval;
        if (c + 1 < NCH) { const float* pc = pg + (size_t)(c + 1) * 4096; p0 = *(const f32x4*)(pc + tid * 8); p1 = *(const f32x4*)(pc + tid * 8 + 4); lval = slot[4096]; }
        lds_barrier();
#pragma unroll 4
        for (int j4 = 0; j4 < 16; ++j4) { const f32x4 p = *(const lf32x4*)(PL + k * 68 + j4 * 4);
#pragma unroll
            for (int q = 0; q < 4; ++q) acc += p[q] * SL[(j4 * 4 + q) * 8 + vv]; }
        *slot = cur;
        lds_barrier();
        cur = acc; SL[k * 8 + vv] = acc;
    }
    const int b = bh >> 2, h = bh & 3;
    a.out[O_PGDN + (size_t)((l * 8 + b) * 4 + h) * 4096 + k * 64 + vb * 8 + vv] = cur;
}
__device__ __forceinline__ void pass2_diag(CArgs& a, int l, int br  , int bh, int quarter) {
    float* ss = (float*)(a.ws + (br == 0 ? WS_SS : WS_SH)) + (size_t)bh * NCH * 4096;
    const float* ds = (const float*)(a.ws + WS_DS) + bh * NCH; const float* dh = (const float*)(a.ws + WS_DH) + (size_t)bh * NCH * 64;
    MK_OPQ(ss); MK_OPQ(ds); MK_OPQ(dh);
    const int e = quarter * 1024 + otid() * 2, k = e >> 6;
    f32x2 lv[NCH]; float dc[NCH];
#pragma unroll
    for (int c = 0; c < NCH; ++c) { lv[c] = *(const f32x2*)(ss + (size_t)c * 4096 + e); dc[c] = br == 0 ? ds[c] : dh[c * 64 + k]; }
    float c0 = 0.f, c1 = 0.f; asm volatile("" : "+v"(c0), "+v"(c1));
#pragma unroll
    for (int c = 0; c < NCH; ++c) { *(f32x2*)(ss + (size_t)c * 4096 + e) = (f32x2){c0, c1}; c0 = dc[c] * c0 + lv[c][0]; c1 = dc[c] * c1 + lv[c][1]; }
    const int b = bh >> 2, h = bh & 3; float* o = a.out + (br == 0 ? O_PSSD : O_PHG) + (size_t)((l * 8 + b) * 4 + h) * 4096 + e;
    o[0] = c0; o[1] = c1;
}
__device__ __forceinline__ void pass2_s5(CArgs& a, int l, int part) {
    const int e = part * 512 + otid(), bg = e >> 6, n = e & 63, b = bg >> 4, g = bg & 15, lg = l * 16 + g;
    const float dt = __expf(a.in[I_LOGDT][lg]); const float lr = a.in[I_LAMR][lg * 64 + n], li = a.in[I_LAMI][lg * 64 + n];
    const float mag = __expf(lr * dt); float sn, cs; { float rv = li * dt * 0.15915494309189535f; rv -= rintf(rv); sn = __builtin_amdgcn_sinf(rv); cs = __builtin_amdgcn_cosf(rv); }
    const float lbr = mag * cs, lbi = mag * sn;
    float pr = 1.f, pi = 0.f;
    for (int i = 0; i < CL; ++i) { const float t = pr * lbr - pi * lbi; pi = pr * lbi + pi * lbr; pr = t; }
    float* h5 = (float*)(a.ws + WS_H5) + (size_t)bg * NCH * 128;
    float hr = 0.f, hi = 0.f; asm volatile("" : "+v"(hr), "+v"(hi));
    float l0v[NCH], l1v[NCH];
#pragma unroll
    for (int c = 0; c < NCH; ++c) { l0v[c] = h5[c * 128 + n]; l1v[c] = h5[c * 128 + 64 + n]; }
#pragma unroll
    for (int c = 0; c < NCH; ++c) { float* s = h5 + c * 128; s[n] = hr; s[64 + n] = hi;
        const float t = pr * hr - pi * hi + l0v[c]; hi = pr * hi + pi * hr + l1v[c]; hr = t; }
    a.out[O_PS5R + (size_t)((l * 8 + b) * 16 + g) * 64 + n] = hr; a.out[O_PS5I + (size_t)((l * 8 + b) * 16 + g) * 64 + n] = hi;
}

#define XB_TMO      128
#define XB_XCNT(j)  (256  + 64 * (j))
#define XB_XSUB(j)  (1280 + 64 * (j))
#define XB_XGEN(j)  (2304 + 64 * (j))
#define XB_TOP      3328
#define XB_TOPGEN   3392
#define XCD_BAR_WORDS 3456
#define XB_SPIN_CAP (1u << 18)

__device__ __forceinline__ unsigned xb_ld(unsigned* p)              { return __hip_atomic_load(p, __ATOMIC_RELAXED, __HIP_MEMORY_SCOPE_AGENT); }
__device__ __forceinline__ unsigned xb_add(unsigned* p, unsigned v) { return __hip_atomic_fetch_add(p, v, __ATOMIC_RELAXED, __HIP_MEMORY_SCOPE_AGENT); }
__device__ __forceinline__ unsigned xb_xcc_id() { return (unsigned)__builtin_amdgcn_s_getreg((3 << 11) | 20) & 0xFu; }
#define XB_SPIN(cond, bar) do { unsigned _sp = 0; while (cond) { __builtin_amdgcn_s_sleep(1); \
    if ((++_sp & 255u) == 0u) { if (xb_ld(&(bar)[XB_TMO])) break; if (_sp > XB_SPIN_CAP) { atomicAdd(&(bar)[XB_TMO], 1u); break; } } } } while (0)

struct XcdBarrier {
    unsigned* bar; unsigned x;
    volatile MK_LAS unsigned* st;
};

__device__ __forceinline__ XcdBarrier xcd_barrier_post(unsigned* bar, volatile MK_LAS unsigned* st) {
    XcdBarrier b; b.bar = bar; b.x = xb_xcc_id(); b.st = st;
    if (threadIdx.x == 0) (void)xb_add(&bar[XB_XCNT(b.x)], 1u);
    return b;
}
__device__ __forceinline__ void xcd_barrier_complete(unsigned* bar, unsigned x, unsigned& nloc, unsigned& nx) {
    const unsigned G = gridDim.x * gridDim.y * gridDim.z;
    unsigned sum, cnt, mine, sp = 0u;
    for (;;) {
        sum = 0u; cnt = 0u; mine = 0u;
#pragma unroll
        for (unsigned j = 0; j < 16; ++j) { const unsigned c = xb_ld(&bar[XB_XCNT(j)]); sum += c; cnt += (c > 0u) ? 1u : 0u; mine = (j == x) ? c : mine; }
        if (sum == G) break;
        __builtin_amdgcn_s_sleep(1);
        if ((++sp & 255u) == 0u) { if (xb_ld(&bar[XB_TMO])) break; if (sp > XB_SPIN_CAP) { atomicAdd(&bar[XB_TMO], 1u); break; } }
    }
    nloc = mine > 0u ? mine : 1u; nx = cnt > 0u ? cnt : 1u;
}

__device__ __forceinline__ void xcd_barrier(const XcdBarrier& b) {
    asm volatile("s_waitcnt vmcnt(0)" ::: "memory");
    __syncthreads();
    if (threadIdx.x == 0) {
        unsigned* bar = b.bar;
        __builtin_amdgcn_s_waitcnt(0);
        unsigned nloc = b.st[0], nx = b.st[1];
        if (nloc == 0u) { xcd_barrier_complete(bar, b.x, nloc, nx); b.st[0] = nloc; b.st[1] = nx; }
        const unsigned old = xb_add(&bar[XB_XSUB(b.x)], 1u);
        const unsigned gen = old / nloc;
        if (old + 1u == (gen + 1u) * nloc) {
            __builtin_amdgcn_fence(__ATOMIC_RELEASE, "agent");
            asm volatile("s_waitcnt vmcnt(0)" ::: "memory");
            const unsigned og = xb_add(&bar[XB_TOP], 1u);
            const unsigned tg = og / nx;
            if (og + 1u == (tg + 1u) * nx) xb_add(&bar[XB_TOPGEN], 1u);
            else XB_SPIN(xb_ld(&bar[XB_TOPGEN]) == tg, bar);
            __builtin_amdgcn_fence(__ATOMIC_ACQUIRE, "agent");
            xb_add(&bar[XB_XGEN(b.x)], 1u);
            asm volatile("s_waitcnt vmcnt(0)" ::: "memory");
        } else {
            XB_SPIN(xb_ld(&bar[XB_XGEN(b.x)]) == gen, bar);
            __builtin_amdgcn_fence(__ATOMIC_ACQUIRE, "agent");
            asm volatile("s_waitcnt vmcnt(0)" ::: "memory");
        }
    }
    __syncthreads();
}

__device__ __forceinline__ void phase_mixer(CArgs& a, unsigned char* lds, int l, int which  ) {
    const int ntasks = which == 1 ? 2064 : 1024;
    for (int task = obid(); task < ntasks; task += gridDim.x) {
        int kind, p0, p1; bool sample = false;
        if (which == 1) {
            if (task < 768) { kind = task >> 8; p0 = (task & 255) >> 4; p1 = task & 15; }
            else if (task < 1024) { kind = 3; p0 = (task - 768) >> 4; p1 = task & 15; }
            else if (task < 1792) { const int r = task - 1024; kind = 4 + (r >> 8); p0 = r & 255; p1 = 0; sample = true; }
            else if (task < 2048) { const int r = task - 1792; kind = 7; p0 = r >> 4; p1 = r & 15; sample = true; }
            else { kind = 8; p0 = task - 2048; p1 = 0; }
        } else {
            if (task < 768) { kind = 4 + (task >> 8); p0 = (task & 255) >> 4; p1 = task & 15; }
            else { kind = 7; p0 = (task - 768) >> 4; p1 = task & 15; }
        }
        switch (kind) {
            case 0: rec_task<1, 0>(a, lds, l, false, p0 >> 1, p0 & 1, p1); break;
            case 1: rec_task<0, 0>(a, lds, l, false, p0 >> 1, p0 & 1, p1); break;
            case 2: rec_task<2, 0>(a, lds, l, false, p0 >> 1, p0 & 1, p1); break;
            case 3: s5_task<0>(a, lds, l, false, p0, p1); break;
            case 4: rec_task<1, 1>(a, lds, l, sample, p0 >> 1, p0 & 1, p1); break;
            case 5: rec_task<0, 1>(a, lds, l, sample, p0 >> 1, p0 & 1, p1); break;
            case 6: rec_task<2, 1>(a, lds, l, sample, p0 >> 1, p0 & 1, p1); break;
            case 7: s5_task<1>(a, lds, l, sample, p0, p1); break;
            default: conv_copy_task(a, l, p0, 16); break;
        }
    }
}
__device__ __forceinline__ void phase_pass2(CArgs& a, unsigned char* lds, int l) {
    for (int task = obid(); task < 528; task += gridDim.x) {
        if (task < 256) pass2_gdn(a, lds, l, task >> 3, task & 7);
        else if (task < 384) pass2_diag(a, l, 0, (task - 256) >> 2, task & 3);
        else if (task < 512) pass2_diag(a, l, 2, (task - 384) >> 2, task & 3);
        else pass2_s5(a, l, task - 512);
    }
}

template <class Epi>
__device__ __forceinline__ void run_gemm(unsigned char* lds, const bf16_t* A, const bf16_t* Bt, int M, int N, int K, const Epi& E) {
    pg8::Gemm g; g.A = A; g.Bt = Bt; g.M = M; g.N = N; g.K = K;
    pg8::StaticOrder S; S.init(M, N, gridDim.x, obid());
    pg8::gemm_phase<Epi, pg8::StaticOrder, false>((PG8_LAS unsigned char*)lds, g, S, E, nullptr);
}

constexpr int N_PHASES = 1 + 7 * DEPTH;
#ifndef MK_ONE_LAUNCH
#define MK_ONE_LAUNCH 1
#endif

__global__ void __launch_bounds__(512, 2) hybrid_fwd(Args a_in) {
    extern __shared__ __attribute__((aligned(16))) unsigned char lds_[];
    const int ph_lo = a_in.ph_lo, ph_hi = a_in.ph_hi;
#if MK_ONE_LAUNCH
    { volatile MK_LAS unsigned* st = (volatile MK_LAS unsigned*)((MK_LAS unsigned char*)lds_ + L_BARST);
      if (threadIdx.x == 0) { st[0] = 0u; st[1] = 0u; }
      __syncthreads();
      (void)xcd_barrier_post((unsigned*)(a_in.ws + WS_CTL), st); }
#endif
    for (int ph = ph_lo; ph < ph_hi; ++ph) {
        if (ph > ph_lo) {
#if MK_ONE_LAUNCH
            if (ph == ph_lo + 1) cg::this_grid().sync();
            else { XcdBarrier xb_; xb_.bar = (unsigned*)(a_in.ws + WS_CTL); xb_.x = xb_xcc_id(); xb_.st = (volatile MK_LAS unsigned*)((MK_LAS unsigned char*)lds_ + L_BARST); xcd_barrier(xb_); }
#endif
        }
        CArgs* ap = (CArgs*)__builtin_amdgcn_kernarg_segment_ptr();
        asm volatile("" : "+s"(ap));
        CArgs& a = *ap;
        unsigned char* lds = lds_;
        if (ph == 0) { phase_prologue(a, lds); continue; }
        const int l = (ph - 1) / 7, sub = (ph - 1) % 7;
#ifdef MK_DOUBLE
        for (int rep = 0; rep < (sub == MK_DOUBLE ? 2 : 1); ++rep)
#endif
        switch (sub) {
            case 0: { EpiU E; E.U = (bf16_t*)(a.ws + WS_U); E.USM = (float*)(a.ws + WS_USM);
                      run_gemm(lds, (const bf16_t*)(a.ws + WS_XB), (const bf16_t*)(a.ws + WS_WTIN) + (size_t)l * NU_PAD * 1024, MP, NU_PAD, 1024, E); } break;
#ifndef MK_NOMIX
            case 1: case 3: phase_mixer(a, lds, l, sub); break;
            case 2: phase_pass2(a, lds, l); break;
#endif
            case 4: { EpiGlu E; E.Y5 = (const bf16_t*)(a.ws + WS_Y5); E.U = (const bf16_t*)(a.ws + WS_U); E.bias = a.in[I_GLUB] + l * 256; E.MIX = (bf16_t*)(a.ws + WS_XB);
                      run_gemm(lds, (const bf16_t*)(a.ws + WS_Y5), (const bf16_t*)(a.ws + WS_WTGLU) + (size_t)l * 256 * 256, MP, 256, 256, E); } break;
            case 5: { EpiOut E; E.out = a.out; E.xmeta = (float*)(a.ws + WS_XMETA);
                      run_gemm(lds, (const bf16_t*)(a.ws + WS_XB), (const bf16_t*)(a.ws + WS_WTOUT) + (size_t)l * 1024 * 1024, MP, 1024, 1024, E); } break;
            default: phase_ln(a, l); break;
        }
    }
}
}

extern "C" void kernel_launch(void* const* d_in, const int* in_sizes, int n_in, void* d_out, int out_size, void* d_ws, size_t ws_size, hipStream_t stream) {
    using namespace mk;
    static int grid = 0;
    if (!grid) {
        int dev = 0, cus = 0, per_cu = 0;
        hipGetDevice(&dev); hipDeviceGetAttribute(&cus, hipDeviceAttributeMultiprocessorCount, dev);
        hipFuncSetAttribute((const void*)hybrid_fwd, hipFuncAttributeMaxDynamicSharedMemorySize, LDS_BYTES);
        hipOccupancyMaxActiveBlocksPerMultiprocessor(&per_cu, (const void*)hybrid_fwd, 512, LDS_BYTES);
        if (per_cu < 1) { fprintf(stderr, "kernel_launch: occupancy query says %d blocks/CU\n", per_cu); per_cu = 1; }
        grid = cus;
        if (n_in != N_IN || (size_t)out_size != O_END || ws_size < WS_CTL + CTL_BYTES) fprintf(stderr, "kernel_launch: unexpected shapes n_in %d out %d ws %zu\n", n_in, out_size, ws_size);
    }
    Args a{};
    for (int i = 0; i < N_IN; ++i) a.in[i] = (const float*)d_in[i];
    a.out = (float*)d_out; a.ws = (unsigned char*)d_ws;
#if MK_ONE_LAUNCH
    (void)hipMemsetAsync((char*)d_ws + WS_CTL, 0, CTL_BYTES, stream);
    a.ph_lo = 0; a.ph_hi = N_PHASES;
    void* args[] = {&a};
    hipError_t e = hipLaunchCooperativeKernel((const void*)hybrid_fwd, dim3(grid), dim3(512), args, LDS_BYTES, stream);
    if (e != hipSuccess) fprintf(stderr, "cooperative launch failed: %s (grid %d)\n", hipGetErrorString(e), grid);
#else
    for (int ph = 0; ph < N_PHASES; ++ph) { a.ph_lo = ph; a.ph_hi = ph + 1; hipLaunchKernelGGL(hybrid_fwd, dim3(grid), dim3(512), LDS_BYTES, stream, a); }
#endif
}
```

```cpp
#include <hip/hip_runtime.h>
#include <hip/hip_cooperative_groups.h>
#include <cstdio>
namespace cg = cooperative_groups;
namespace pg8 {
#define PG8_LAS __attribute__((address_space(3)))
typedef unsigned short bf16_t;
typedef short bf16x8 __attribute__((ext_vector_type(8)));
typedef float f32x4 __attribute__((ext_vector_type(4)));
typedef unsigned u32x4 __attribute__((ext_vector_type(4)));
constexpr int BM = 256, BK = 64, HALF = 128, HTB = HALF * BK * 2  , STAGE_BYTES = 8 * HTB, NXCD = 8, WGM = 8;

__host__ __device__ __forceinline__ int lds_byte(int r, int c) { const int st = (r >> 4) * 2 + (c >> 5), rr = r & 15, cc = c & 31, ob = rr * 64 + cc * 2; return st * 1024 + (ob ^ (((ob >> 9) & 1) << 5)); }
__host__ __device__ __forceinline__ void stage_rc(int b, int& R, int& C) { const int st = b / 1024, sb = b % 1024, swz = sb ^ (((sb >> 9) & 1) << 5); R = (st >> 1) * 16 + swz / 64; C = (st & 1) * 32 + (swz % 64) / 2; }
__host__ __device__ __forceinline__ int perm32(int rho) { const int n = rho >> 4, i = rho & 15; return 8 * (i >> 2) + 4 * n + (i & 3); }

struct Unit { int pm, pn; };
struct Gemm { const bf16_t* A; const bf16_t* Bt; int M, N, K; };

struct StaticOrder {
    int nM, nN, nwg, G, c;
    __host__ __device__ void init(int M, int N, int G_, int c_) { nM = M / BM; nN = N / BM; nwg = nM * nN; G = G_; c = c_; }
    __host__ __device__ bool next(int i, Unit& u) const {
        const int L = i * G + c; if (L >= nwg) return false;
        int wgid = L; { const int q = nwg / NXCD, r = nwg % NXCD, xcd = wgid % NXCD, off = wgid / NXCD; wgid = (xcd < r ? xcd * (q + 1) : r * (q + 1) + (xcd - r) * q) + off; }
        const int nig = WGM * nN, gid = wgid / nig, fm = gid * WGM, gsz = (nM - fm) < WGM ? (nM - fm) : WGM;
        u.pm = fm + ((wgid % nig) % gsz); u.pn = (wgid % nig) / gsz; return true;
    }
    __device__ __forceinline__ void a_ready(const Unit&) const {}
    __device__ __forceinline__ void done(const Unit&) const {}
};
__device__ __forceinline__ unsigned cvt_pk_bf16(float lo, float hi) { unsigned r; asm volatile("v_cvt_pk_bf16_f32 %0, %1, %2" : "=v"(r) : "v"(lo), "v"(hi)); return r; }
typedef float f32x2 __attribute__((ext_vector_type(2)));
template <class Epi, class Sched, bool STAMP = false>
__device__ __forceinline__ void gemm_phase(PG8_LAS unsigned char* lds, const Gemm g, const Sched& S, const Epi& E, unsigned long long* stamps) {
    int tid_ = threadIdx.x; asm volatile("" : "+v"(tid_)); const int tid = tid_, wid = __builtin_amdgcn_readfirstlane(tid >> 6), lane = tid & 63, wr = wid >> 2, wc = wid & 3, fr = lane & 15, fq = lane >> 4;
    const int K = g.K, nt = K / BK;
    int ts_lo = 0, ts_hi = 0, nts = 0; const unsigned long long rt_entry = STAMP ? (unsigned long long)wall_clock64() : 0ull;
#define PG8_STAMP() do { if (STAMP && wid == 0 && nts < 64) { const unsigned long long _c = (unsigned long long)clock64(); \
        ts_lo = (lane == nts) ? (int)(unsigned)_c : ts_lo; ts_hi = (lane == nts) ? (int)(unsigned)(_c >> 32) : ts_hi; ++nts; } } while (0)
    PG8_STAMP();
    unsigned voffA[2], voffB[2];
#pragma unroll
    for (int i = 0; i < 2; ++i) { int R, C; stage_rc(tid * 16 + i * 8192, R, C); const int Rb = Epi::PERM ? ((R & ~31) + perm32(R & 31)) : R;
        voffA[i] = (unsigned)(R * K + C) * 2u; voffB[i] = (unsigned)(Rb * K + C) * 2u; }
    const size_t kstep = (size_t)(BK * 2);
    const size_t hstep = (size_t)HALF * K * 2;
    const size_t tstep = 2 * hstep;
    const unsigned ldsw = (unsigned)wid * 1024u;
    const int aoff = lds_byte(wr * 64 + fr, fq * 8), boff = lds_byte(wc * 32 + fr, fq * 8);
#define PG8_SA(b, h) (((b) * 2 + (h)) * HTB)
#define PG8_SB(b, h) ((4 + (b) * 2 + (h)) * HTB)
#define PG8_STAGE(bufoff, gbase, voff) do { _Pragma("unroll") for (int _i = 0; _i < 2; ++_i) \
        __builtin_amdgcn_global_load_lds((const unsigned*)((const char*)(gbase) + (voff)[_i]), (PG8_LAS unsigned*)(lds + (bufoff) + ldsw + _i * 8192), 16, 0, 0); } while (0)
#define PG8_LDA(dst, b, h) do { _Pragma("unroll") for (int m = 0; m < 4; ++m) _Pragma("unroll") for (int k = 0; k < 2; ++k) dst[m][k] = *(const PG8_LAS bf16x8*)(lds + PG8_SA(b, h) + aoff + m * 2048 + k * 1024); } while (0)
#define PG8_LDB(dst, b, h) do { _Pragma("unroll") for (int n = 0; n < 2; ++n) _Pragma("unroll") for (int k = 0; k < 2; ++k) dst[n][k] = *(const PG8_LAS bf16x8*)(lds + PG8_SB(b, h) + boff + n * 2048 + k * 1024); } while (0)
#define PG8_MMA(ai, bj, At, Bt) do { __builtin_amdgcn_s_setprio(1); _Pragma("unroll") for (int m = 0; m < 4; ++m) _Pragma("unroll") for (int n = 0; n < 2; ++n) _Pragma("unroll") for (int k = 0; k < 2; ++k) \
        acc[ai][bj][m][n] = __builtin_amdgcn_mfma_f32_16x16x32_bf16(Bt[n][k], At[m][k], acc[ai][bj][m][n], 0, 0, 0); __builtin_amdgcn_s_setprio(0); } while (0)
#define PG8_WAIT_V(n) asm volatile("s_waitcnt vmcnt(" #n ")" ::: "memory")
#define PG8_WAIT_L(n) asm volatile("s_waitcnt lgkmcnt(" #n ")" ::: "memory")
#define PG8_BAR __builtin_amdgcn_s_barrier()
#define PG8_SCHED __builtin_amdgcn_sched_barrier(0)
    Unit cur, nxt; int ui = 0;
    if (!S.next(0, cur)) return;
    f32x4 acc[2][2][4][2];
#pragma unroll
    for (int a = 0; a < 2; ++a)
#pragma unroll
        for (int b = 0; b < 2; ++b)
#pragma unroll
            for (int m = 0; m < 4; ++m)
#pragma unroll
                for (int n = 0; n < 2; ++n) acc[a][b][m][n] = (f32x4){0.f, 0.f, 0.f, 0.f};
    bf16x8 At[4][2], B0[2][2], B1[2][2];
    const char* cA = (const char*)g.A + (size_t)cur.pm * tstep; const char* cB = (const char*)g.Bt + (size_t)cur.pn * tstep;
    S.a_ready(cur);
    PG8_STAGE(PG8_SB(0, 0), cB, voffB); PG8_STAGE(PG8_SA(0, 0), cA, voffA); PG8_STAGE(PG8_SB(0, 1), cB + hstep, voffB); PG8_STAGE(PG8_SA(0, 1), cA + hstep, voffA);
    if (wr == 1) PG8_BAR;
    PG8_WAIT_V(4); PG8_BAR;
    PG8_STAGE(PG8_SB(1, 0), cB + kstep, voffB); PG8_STAGE(PG8_SA(1, 0), cA + kstep, voffA); PG8_STAGE(PG8_SB(1, 1), cB + hstep + kstep, voffB);
    PG8_WAIT_V(6); PG8_BAR;
    PG8_STAMP();
    for (;;) {
        const bool has_next = S.next(ui + 1, nxt);
        const char* nA = has_next ? (const char*)g.A + (size_t)nxt.pm * tstep : cA; const char* nB = has_next ? (const char*)g.Bt + (size_t)nxt.pn * tstep : cB;
        for (int t = 0; t < nt; t += 2) {
            const bool last = (t == nt - 2);
            const char* a1 = cA + (size_t)(t + 1) * kstep;
            const char* a2 = last ? nA : cA + (size_t)(t + 2) * kstep; const char* b2 = last ? nB : cB + (size_t)(t + 2) * kstep;
            const char* a3 = a2 + kstep; const char* b3 = b2 + kstep;
            if (last && has_next) S.a_ready(nxt);
            PG8_LDB(B0, 0, 0); PG8_SCHED; PG8_LDA(At, 0, 0); PG8_STAGE(PG8_SA(1, 1), a1 + hstep, voffA);
            PG8_WAIT_L(8); PG8_BAR; PG8_WAIT_L(0); PG8_MMA(0, 0, At, B0); PG8_BAR; PG8_SCHED;
            PG8_LDB(B1, 0, 1); PG8_STAGE(PG8_SB(0, 0), b2, voffB);
            PG8_BAR; PG8_WAIT_L(0); PG8_MMA(0, 1, At, B1); PG8_BAR;
            PG8_LDA(At, 0, 1); PG8_STAGE(PG8_SA(0, 0), a2, voffA);
            PG8_BAR; PG8_WAIT_L(0); PG8_MMA(1, 0, At, B0); PG8_BAR; PG8_SCHED;
            PG8_STAGE(PG8_SB(0, 1), b2 + hstep, voffB);
            PG8_WAIT_V(6); PG8_BAR; PG8_MMA(1, 1, At, B1); PG8_BAR;
            PG8_LDB(B0, 1, 0); PG8_SCHED; PG8_LDA(At, 1, 0); PG8_STAGE(PG8_SA(0, 1), a2 + hstep, voffA);
            PG8_WAIT_L(8); PG8_BAR; PG8_WAIT_L(0); PG8_MMA(0, 0, At, B0); PG8_BAR; PG8_SCHED;
            PG8_LDB(B1, 1, 1); PG8_STAGE(PG8_SB(1, 0), b3, voffB);
            PG8_BAR; PG8_WAIT_L(0); PG8_MMA(0, 1, At, B1); PG8_BAR;
            PG8_LDA(At, 1, 1); PG8_STAGE(PG8_SA(1, 0), a3, voffA);
            PG8_BAR; PG8_WAIT_L(0); PG8_MMA(1, 0, At, B0); PG8_BAR; PG8_SCHED;
            PG8_STAGE(PG8_SB(1, 1), b3 + hstep, voffB);
            PG8_WAIT_V(6); PG8_BAR; PG8_MMA(1, 1, At, B1); PG8_BAR;
        }
        PG8_STAMP();
        if constexpr (!Epi::AFTER_DRAIN) { E(acc, cur, wr, wc, fr, fq); S.done(cur); }
        PG8_STAMP();
        if (!has_next) break;
#pragma unroll
        for (int a = 0; a < 2; ++a)
#pragma unroll
            for (int b = 0; b < 2; ++b)
#pragma unroll
                for (int m = 0; m < 4; ++m)
#pragma unroll
                    for (int n = 0; n < 2; ++n) acc[a][b][m][n] = (f32x4){0.f, 0.f, 0.f, 0.f};
        cur = nxt; cA = nA; cB = nB; ++ui;
    }
    PG8_WAIT_V(0);
    if (wr == 0) PG8_BAR;
    PG8_BAR;
    if constexpr (Epi::AFTER_DRAIN) { E.fused(acc, cur, wr, wc, fr, fq, lds, wid, lane); S.done(cur); }
    PG8_STAMP();
    if (STAMP && wid == 0) { stamps[lane] = lane < nts ? (((unsigned long long)(unsigned)ts_hi << 32) | (unsigned)ts_lo) : 0ull;
        if (lane == 62) stamps[62] = rt_entry; if (lane == 63) stamps[63] = (unsigned long long)wall_clock64(); }
#undef PG8_STAMP
#undef PG8_SA
#undef PG8_SB
#undef PG8_STAGE
#undef PG8_LDA
#undef PG8_LDB
#undef PG8_MMA
#undef PG8_WAIT_V
#undef PG8_WAIT_L
#undef PG8_BAR
#undef PG8_SCHED
}
}

namespace mk {
using pg8::bf16_t; using pg8::f32x4; using pg8::u32x4; using pg8::Unit; using pg8::cvt_pk_bf16;
typedef unsigned u32x2 __attribute__((ext_vector_type(2)));
using pg8::f32x2;
#define MK_LAS __attribute__((address_space(3)))
typedef MK_LAS float lfloat;
typedef MK_LAS f32x4 lf32x4;

constexpr int D = 1024, DEPTH = 4, TP = 2064, BP = 8, BS = 128, TS = 4;
constexpr int M_REAL = 17024, MP = 17152, ROW_SAMPLE = 16384, ROW_META = 16896;
constexpr int D_IN = 3340, NU = 3328, NU_PAD = 3584;
constexpr int CL = 129, NCH = 16, ST = 43;
constexpr int UC_ZA = 0, UC_XBC = 256, UC_ZB = 768, UC_UB = 1024, UC_ZC = 1280, UC_QKV = 1536, UC_ZD = 2304, UC_QD = 2560, UC_FD = 2816, UC_ID = 3072;
constexpr float DN_ALPHA = 1.6817928305074290f;
constexpr float LN_EPS = 1e-5f, RMS_EPS = 1e-6f, L2_EPS = 1e-6f;

enum { I_XP = 0, I_XS, I_SSSD, I_SSSDC, I_SS5R, I_SS5I, I_SGDN, I_SGDNC, I_SHG, I_META, I_LNIG, I_LNIB, I_WIN, I_SCW, I_SCB, I_SDTB, I_SALOG, I_SD, I_SNG,
       I_LAMR, I_LAMI, I_LOGDT, I_BR, I_BI, I_CR, I_CI, I_S5D, I_GLUW, I_GLUB, I_GCW, I_GCB, I_GALOG, I_GDTB, I_GNG, I_HLB, I_HNG, I_WOUT, I_LNG, I_LNB, N_IN };

constexpr size_t O_YP = 0, O_YS = O_YP + (size_t)8 * 2048 * 1024, O_PSSD = O_YS + (size_t)128 * 4 * 1024;
constexpr size_t SZ_ST = 4 * 64 * 64, SZ_SC = 3 * 512, SZ_S5 = 16 * 64, SZ_GC = 3 * 768;
constexpr size_t O_PSSDC = O_PSSD + 4 * 8 * SZ_ST, O_PS5R = O_PSSDC + 4 * 8 * SZ_SC, O_PS5I = O_PS5R + 4 * 8 * SZ_S5, O_PGDN = O_PS5I + 4 * 8 * SZ_S5,
                 O_PGDNC = O_PGDN + 4 * 8 * SZ_ST, O_PHG = O_PGDNC + 4 * 8 * SZ_GC, O_SSSD = O_PHG + 4 * 8 * SZ_ST, O_SSSDC = O_SSSD + 4 * 128 * SZ_ST,
                 O_SS5R = O_SSSDC + 4 * 128 * SZ_SC, O_SS5I = O_SS5R + 4 * 128 * SZ_S5, O_SGDN = O_SS5I + 4 * 128 * SZ_S5, O_SGDNC = O_SGDN + 4 * 128 * SZ_ST,
                 O_SHG = O_SGDNC + 4 * 128 * SZ_GC, O_END = O_SHG + 4 * 128 * SZ_ST;
static_assert(O_END == 47243264, "d_out size");

constexpr size_t WS_WTIN = 0;
constexpr size_t WS_WTOUT = WS_WTIN + (size_t)4 * NU_PAD * 1024 * 2;
constexpr size_t WS_WTGLU = WS_WTOUT + (size_t)4 * 1024 * 1024 * 2;
constexpr size_t WS_XB = WS_WTGLU + (size_t)4 * 256 * 256 * 2;
constexpr size_t WS_XMETA = WS_XB + (size_t)MP * 1024 * 2;
constexpr size_t WS_U = WS_XMETA + (size_t)128 * 1024 * 4;
constexpr size_t WS_USM = WS_U + (size_t)MP * NU * 2;
constexpr size_t WS_Y5 = WS_USM + (size_t)MP * 16 * 4;
constexpr size_t WS_SG = WS_Y5 + (size_t)MP * 256 * 2;
constexpr size_t WS_PG = WS_SG + (size_t)32 * 16 * 4096 * 4;
constexpr size_t WS_SS = WS_PG + (size_t)32 * 16 * 4096 * 4;
constexpr size_t WS_SH = WS_SS + (size_t)32 * 16 * 4096 * 4;
constexpr size_t WS_DS = WS_SH + (size_t)32 * 16 * 4096 * 4;
constexpr size_t WS_DH = WS_DS + 4096;
constexpr size_t WS_H5 = WS_DH + (size_t)32 * 16 * 64 * 4;
constexpr size_t WS_END = WS_H5 + (size_t)8 * 16 * 16 * 128 * 4;
constexpr size_t WS_CTL = WS_END;
constexpr size_t CTL_BYTES = 16384;
static_assert(WS_CTL + CTL_BYTES <= 268435456, "ws");
constexpr int L_BARST = 147456 - 16;

constexpr int LDS_BYTES = 147456;
constexpr int H_RAW = 0, H_ACT = 17664, H_ZB = 61696, H_SCAL = 67200, H_MISC = 67712, H_CWL = 67968, H_STRIDE = 71808, H_OBUF = H_RAW;
static_assert(H_ACT == (ST + 3) * 192 * 2 && H_ZB == H_ACT + ST * 256 * 4 && H_SCAL == H_ZB + ST * 64 * 2 && ST * 64 * 4 <= H_ACT && (2 * ST + 1) * 4 <= 512, "lds map");
static_assert(2 * 16640 <= H_ZB && 2 * H_STRIDE <= 147456 - 16, "lds");

struct Args { const float* in[N_IN]; float* out; unsigned char* ws; int ph_lo, ph_hi; };
typedef __attribute__((address_space(4))) const Args CArgs;

__device__ __forceinline__ int otid() { int t = threadIdx.x; asm volatile("" : "+v"(t)); return t; }
#define MK_OPQ(p) asm volatile("" : "+s"(p))
__device__ __forceinline__ int obid() { int t = blockIdx.x; asm volatile("" : "+s"(t)); return t; }
__device__ __forceinline__ float bf2f(bf16_t v) { return __uint_as_float(((unsigned)v) << 16); }
__device__ __forceinline__ bf16_t f2bf(float f) { unsigned u = __float_as_uint(f); return (bf16_t)((u + 0x7fffu + ((u >> 16) & 1u)) >> 16); }
__device__ __forceinline__ unsigned pk2(float lo, float hi) { return (unsigned)f2bf(lo) | ((unsigned)f2bf(hi) << 16); }
__device__ __forceinline__ float sigm(float x) { return __builtin_amdgcn_rcpf(1.f + __expf(-x)); }
__device__ __forceinline__ float silu(float x) { return x * __builtin_amdgcn_rcpf(1.f + __expf(-x)); }
__device__ __forceinline__ float softplus(float x) { const float e = __expf(x); return x > 15.f ? x : (e < 0.01f ? e * (1.f - e * (0.5f - e * 0.33333333f)) : __logf(1.f + e)); }
__device__ __forceinline__ float gelu_tanh(float x) { const float u = 0.7978845608028654f * (x + 0.044715f * x * x * x); const float t = __expf(2.f * u); return 0.5f * x * (2.f - 2.f * __builtin_amdgcn_rcpf(1.f + t)); }
__device__ __forceinline__ float wave_sum(float v, int lane) {
#pragma unroll
    for (int o = 1; o < 64; o <<= 1) v += __builtin_bit_cast(float, __builtin_amdgcn_ds_bpermute((lane ^ o) << 2, __builtin_bit_cast(int, v)));
    return v;
}
__device__ __forceinline__ float red8(float x) {
    x += __builtin_bit_cast(float, __builtin_amdgcn_update_dpp(0, __builtin_bit_cast(int, x), 0xB1, 0xF, 0xF, true));
    x += __builtin_bit_cast(float, __builtin_amdgcn_update_dpp(0, __builtin_bit_cast(int, x), 0x4E, 0xF, 0xF, true));
    x += __builtin_bit_cast(float, __builtin_amdgcn_update_dpp(0, __builtin_bit_cast(int, x), 0x141, 0xF, 0xF, true));
    return x;
}
__device__ __forceinline__ void lds_barrier() { asm volatile("s_waitcnt lgkmcnt(0)" ::: "memory"); __builtin_amdgcn_s_barrier(); asm volatile("" ::: "memory"); }
__device__ __forceinline__ int prow(int b, int t) { return t < 16 ? ROW_META + b * 16 + t : b * 2048 + t - 16; }
__device__ __forceinline__ float* xrow_ptr(CArgs& a, int row) { return row < ROW_META ? a.out + (size_t)row * D : (float*)(a.ws + WS_XMETA) + (size_t)(row - ROW_META) * D; }

__device__ __forceinline__ void transpose_item(const float* W, int ldw, int K, int k0, int ns0, bf16_t* WT, int nd0, lfloat* scr, int lane) {
#pragma unroll 8
    for (int i = 0; i < 32; ++i) { const int kk = 2 * i + (lane >> 5); scr[kk * 33 + (lane & 31)] = W[(size_t)(k0 + kk) * ldw + ns0 + (lane & 31)]; }
    __builtin_amdgcn_wave_barrier(); asm volatile("s_waitcnt lgkmcnt(0)" ::: "memory");
    const int c = lane & 7;
#pragma unroll
    for (int j = 0; j < 4; ++j) { const int n = (lane >> 3) + 8 * j; const lfloat* s = scr + (8 * c) * 33 + n;
        u32x4 o; o.x = pk2(s[0 * 33], s[1 * 33]); o.y = pk2(s[2 * 33], s[3 * 33]); o.z = pk2(s[4 * 33], s[5 * 33]); o.w = pk2(s[6 * 33], s[7 * 33]);
        *(u32x4*)(WT + (size_t)(nd0 + n) * K + k0 + 8 * c) = o; }
    __builtin_amdgcn_wave_barrier(); asm volatile("s_waitcnt lgkmcnt(0)" ::: "memory");
}
__device__ __forceinline__ void ln_row(const float* src, const float* g, const float* bb, float* dstf, bf16_t* dstb, int lane) {
    const f32x4* xr = (const f32x4*)src + lane;
    f32x4 v[4]; float s = 0.f;
#pragma unroll
    for (int j = 0; j < 4; ++j) { v[j] = xr[64 * j]; s += (v[j].x + v[j].y) + (v[j].z + v[j].w); }
    const float mean = wave_sum(s, lane) * (1.f / D); float s2 = 0.f;
#pragma unroll
    for (int j = 0; j < 4; ++j) { v[j] = v[j] - mean; s2 += (v[j].x * v[j].x + v[j].y * v[j].y) + (v[j].z * v[j].z + v[j].w * v[j].w); }
    const float rstd = __builtin_amdgcn_rsqf(wave_sum(s2, lane) * (1.f / D) + LN_EPS);
#pragma unroll
    for (int j = 0; j < 4; ++j) {
        const f32x4 gv = ((const f32x4*)g)[lane + 64 * j], bv = ((const f32x4*)bb)[lane + 64 * j];
        const f32x4 o = v[j] * rstd * gv + bv;
        ((f32x4*)dstf)[lane + 64 * j] = o;
        u32x2 w; w.x = pk2(o.x, o.y); w.y = pk2(o.z, o.w);
        ((u32x2*)dstb)[lane + 64 * j] = w;
    }
}

__device__ __forceinline__ void phase_prologue(CArgs& a, unsigned char* ldsg) {
    const int tid = otid(), lane = tid & 63, wave = tid >> 6;
    lfloat* scr = (lfloat*)(MK_LAS unsigned char*)ldsg + wave * 4096;
    const int gw = obid() * 8 + wave, NGW = gridDim.x * 8;
    constexpr int I_IN = 16 * (NU / 32), I_OUT = 16 * 32, I_GLU = 4 * 8;
    constexpr int NITEMS = 4 * (I_IN + I_OUT + I_GLU);
    bf16_t* wtin = (bf16_t*)(a.ws + WS_WTIN); bf16_t* wtout = (bf16_t*)(a.ws + WS_WTOUT); bf16_t* wtglu = (bf16_t*)(a.ws + WS_WTGLU);
    for (int it = gw; it < NITEMS; it += NGW) {
        int r = it;
        if (r < 4 * I_IN) { const int l = r / I_IN; r -= l * I_IN; const int kb = r / (NU / 32), nb = r % (NU / 32); const int nd0 = nb * 32; const int ns0 = nd0 + (nd0 >= 768 ? 4 : 0) + (nd0 >= 2304 ? 8 : 0);
            transpose_item(a.in[I_WIN] + (size_t)l * 1024 * D_IN, D_IN, 1024, kb * 64, ns0, wtin + (size_t)l * NU_PAD * 1024, nd0, scr, lane); continue; }
        r -= 4 * I_IN;
        if (r < 4 * I_OUT) { const int l = r / I_OUT; r -= l * I_OUT; const int kb = r / 32, nb = r % 32;
            transpose_item(a.in[I_WOUT] + (size_t)l * 1024 * 1024, 1024, 1024, kb * 64, nb * 32, wtout + (size_t)l * 1024 * 1024, nb * 32, scr, lane); continue; }
        r -= 4 * I_OUT;
        { const int l = r / I_GLU; r -= l * I_GLU; const int kb = r / 8, nb = r % 8;
            transpose_item(a.in[I_GLUW] + (size_t)l * 256 * 256, 256, 256, kb * 64, nb * 32, wtglu + (size_t)l * 256 * 256, nb * 32, scr, lane); }
    }
    for (int idx = obid() * 512 + tid; idx < 4 * 12 * 1024; idx += gridDim.x * 512) {
        const int l = idx / (12 * 1024), r = idx % (12 * 1024), j = r >> 10, k = r & 1023; const int sc = j < 4 ? 768 + j : 2308 + (j - 4);
        wtin[((size_t)l * NU_PAD + NU + j) * 1024 + k] = f2bf(a.in[I_WIN][((size_t)l * 1024 + k) * D_IN + sc]);
    }
    bf16_t* xb = (bf16_t*)(a.ws + WS_XB);
    for (int row = gw; row < M_REAL; row += NGW) {
        const float* src = row < ROW_SAMPLE ? a.in[I_XP] + (size_t)row * D : (row < ROW_META ? a.in[I_XS] + (size_t)(row - ROW_SAMPLE) * D : a.in[I_META] + (size_t)((row - ROW_META) & 15) * D);
        ln_row(src, a.in[I_LNIG], a.in[I_LNIB], xrow_ptr(a, row), xb + (size_t)row * D, lane);
    }
}
__device__ __forceinline__ void ln_row2(const float* src0, const float* src1, const float* g, const float* bb, float* d0, float* d1, bf16_t* b0, bf16_t* b1, int lane, const bool write_b = true) {
    const f32x4* x0 = (const f32x4*)src0 + lane; const f32x4* x1 = (const f32x4*)src1 + lane;
    f32x4 v0[4], v1[4]; float s0 = 0.f, s1 = 0.f;
#pragma unroll
    for (int j = 0; j < 4; ++j) { v0[j] = x0[64 * j]; v1[j] = x1[64 * j]; }
#pragma unroll
    for (int j = 0; j < 4; ++j) { s0 += (v0[j].x + v0[j].y) + (v0[j].z + v0[j].w); s1 += (v1[j].x + v1[j].y) + (v1[j].z + v1[j].w); }
#pragma unroll
    for (int o = 1; o < 64; o <<= 1) { s0 += __builtin_bit_cast(float, __builtin_amdgcn_ds_bpermute((lane ^ o) << 2, __builtin_bit_cast(int, s0))); s1 += __builtin_bit_cast(float, __builtin_amdgcn_ds_bpermute((lane ^ o) << 2, __builtin_bit_cast(int, s1))); }
    const float m0 = s0 * (1.f / D), m1 = s1 * (1.f / D); float q0 = 0.f, q1 = 0.f;
#pragma unroll
    for (int j = 0; j < 4; ++j) { v0[j] = v0[j] - m0; v1[j] = v1[j] - m1; q0 += (v0[j].x * v0[j].x + v0[j].y * v0[j].y) + (v0[j].z * v0[j].z + v0[j].w * v0[j].w); q1 += (v1[j].x * v1[j].x + v1[j].y * v1[j].y) + (v1[j].z * v1[j].z + v1[j].w * v1[j].w); }
#pragma unroll
    for (int o = 1; o < 64; o <<= 1) { q0 += __builtin_bit_cast(float, __builtin_amdgcn_ds_bpermute((lane ^ o) << 2, __builtin_bit_cast(int, q0))); q1 += __builtin_bit_cast(float, __builtin_amdgcn_ds_bpermute((lane ^ o) << 2, __builtin_bit_cast(int, q1))); }
    const float r0 = __builtin_amdgcn_rsqf(q0 * (1.f / D) + LN_EPS), r1 = __builtin_amdgcn_rsqf(q1 * (1.f / D) + LN_EPS);
#pragma unroll
    for (int j = 0; j < 4; ++j) {
        const f32x4 gv = ((const f32x4*)g)[lane + 64 * j], bv = ((const f32x4*)bb)[lane + 64 * j];
        const f32x4 o0 = v0[j] * r0 * gv + bv, o1 = v1[j] * r1 * gv + bv;
        ((f32x4*)d0)[lane + 64 * j] = o0; ((f32x4*)d1)[lane + 64 * j] = o1;
        u32x2 w0, w1; w0.x = pk2(o0.x, o0.y); w0.y = pk2(o0.z, o0.w); w1.x = pk2(o1.x, o1.y); w1.y = pk2(o1.z, o1.w);
        if (write_b) { ((u32x2*)b0)[lane + 64 * j] = w0; ((u32x2*)b1)[lane + 64 * j] = w1; }
    }
}
__device__ __forceinline__ void phase_ln(CArgs& a, int l) {
    const int lane = otid() & 63, wave = otid() >> 6, bid = obid();
    bf16_t* xb = (bf16_t*)(a.ws + WS_XB);
    const float* g = a.in[I_LNG] + l * D; const float* bb = a.in[I_LNB] + l * D;
    if (gridDim.x == 256) {
        const int x = bid & 7, wx = (bid >> 3) * 8 + wave;
        for (int p = wx; p < 1024; p += 256) { const int row = 2048 * x + 2 * p; float* x0 = xrow_ptr(a, row); float* x1 = xrow_ptr(a, row + 1);
            ln_row2(x0, x1, g, bb, x0, x1, xb + (size_t)row * D, xb + (size_t)(row + 1) * D, lane, l != DEPTH - 1); }
        const int gw = bid * 8 + wave;
        if (gw < (M_REAL - 16384) / 2) { const int row = 16384 + 2 * gw; float* x0 = xrow_ptr(a, row); float* x1 = xrow_ptr(a, row + 1);
            ln_row2(x0, x1, g, bb, x0, x1, xb + (size_t)row * D, xb + (size_t)(row + 1) * D, lane, l != DEPTH - 1); }
    } else {
        const int gw = bid * 8 + wave, NGW = gridDim.x * 8;
        for (int row = gw * 2; row < M_REAL; row += NGW * 2) { float* x0 = xrow_ptr(a, row); float* x1 = xrow_ptr(a, row + 1);
            ln_row2(x0, x1, g, bb, x0, x1, xb + (size_t)row * D, xb + (size_t)(row + 1) * D, lane, l != DEPTH - 1); }
    }
}

struct EpiU {
    static constexpr bool PERM = true, AFTER_DRAIN = false;
    bf16_t* U; float* USM;
    __device__ __forceinline__ void operator()(const f32x4 (&acc)[2][2][4][2], const Unit& u, int wr_, int wc_, int fr_, int fq_) const {
        const int tid = otid(), lane = tid & 63, wid = __builtin_amdgcn_readfirstlane(tid >> 6), wr = wid >> 2, wc = wid & 3, fr = lane & 15, fq = lane >> 4;
        const int row0 = u.pm * 256 + wr * 64 + fr;
        if (u.pn < 13) {
            const int col0 = u.pn * 256 + wc * 32 + 8 * fq;
#pragma unroll
            for (int ai = 0; ai < 2; ++ai)
#pragma unroll
                for (int m = 0; m < 4; ++m) { bf16_t* rowp = U + (size_t)(row0 + ai * 128 + m * 16) * NU + col0;
#pragma unroll
                    for (int bj = 0; bj < 2; ++bj) { const f32x4 v0 = acc[ai][bj][m][0], v1 = acc[ai][bj][m][1];
                        u32x4 w; w.x = cvt_pk_bf16(v0[0], v0[1]); w.y = cvt_pk_bf16(v0[2], v0[3]); w.z = cvt_pk_bf16(v1[0], v1[1]); w.w = cvt_pk_bf16(v1[2], v1[3]);
                        *(u32x4*)(rowp + bj * 128) = w; }
                    asm volatile("" ::: "memory"); }
        } else if (wc == 0 && fq < 2) {
#pragma unroll
            for (int ai = 0; ai < 2; ++ai)
#pragma unroll
                for (int m = 0; m < 4; ++m) { float* rowp = USM + (size_t)(row0 + ai * 128 + m * 16) * 16 + 8 * fq;
                    *(f32x4*)(rowp) = acc[ai][0][m][0]; *(f32x4*)(rowp + 4) = acc[ai][0][m][1]; }
        }
    }
};
struct EpiGlu {
    static constexpr bool PERM = true, AFTER_DRAIN = false;
    const bf16_t* Y5; const bf16_t* U; const float* bias; bf16_t* MIX;
    __device__ __forceinline__ void operator()(const f32x4 (&acc)[2][2][4][2], const Unit& u, int wr_, int wc_, int fr_, int fq_) const {
        const int tid = otid(), lane = tid & 63, wid = __builtin_amdgcn_readfirstlane(tid >> 6), wr = wid >> 2, wc = wid & 3, fr = lane & 15, fq = lane >> 4;
        const int row0 = u.pm * 256 + wr * 64 + fr, col0 = wc * 32 + 8 * fq;
#pragma unroll
        for (int ai = 0; ai < 2; ++ai)
#pragma unroll
            for (int m = 0; m < 4; ++m) { const size_t row = (size_t)(row0 + ai * 128 + m * 16);
                u32x4 yv[2], zv[2];
#pragma unroll
                for (int bj = 0; bj < 2; ++bj) { const int col = col0 + bj * 128; yv[bj] = *(const u32x4*)(Y5 + row * 256 + col); zv[bj] = *(const u32x4*)(U + row * NU + UC_ZB + col); }
#pragma unroll
                for (int bj = 0; bj < 2; ++bj) { const int col = col0 + bj * 128;
                    const f32x4 b0 = *(const f32x4*)(bias + col), b1 = *(const f32x4*)(bias + col + 4);
                    float o[8];
#pragma unroll
                    for (int j = 0; j < 8; ++j) { const float g = (j < 4 ? acc[ai][bj][m][0][j & 3] : acc[ai][bj][m][1][j & 3]) + (j < 4 ? b0[j & 3] : b1[j & 3]);
                        const unsigned yw = yv[bj][j >> 1], zw = zv[bj][j >> 1];
                        const float y = __uint_as_float((j & 1) ? (yw & 0xffff0000u) : (yw << 16)), z = __uint_as_float((j & 1) ? (zw & 0xffff0000u) : (zw << 16));
                        o[j] = y * sigm(g) * silu(z); }
                    u32x4 w; w.x = pk2(o[0], o[1]); w.y = pk2(o[2], o[3]); w.z = pk2(o[4], o[5]); w.w = pk2(o[6], o[7]);
                    *(u32x4*)(MIX + row * 1024 + 256 + col) = w; }
                asm volatile("" ::: "memory"); }
    }
};
struct EpiOut {
    static constexpr bool PERM = false, AFTER_DRAIN = false;
    float* out; float* xmeta;
    __device__ __forceinline__ void operator()(const f32x4 (&acc)[2][2][4][2], const Unit& u, int wr_, int wc_, int fr_, int fq_) const {
        const int tid = otid(), lane = tid & 63, wid = __builtin_amdgcn_readfirstlane(tid >> 6), wr = wid >> 2, wc = wid & 3, fr = lane & 15, fq = lane >> 4;
        const int row0 = u.pm * 256 + wr * 64 + fr, col0 = u.pn * 256 + wc * 32 + 4 * fq;
#pragma unroll
        for (int ai = 0; ai < 2; ++ai) { const int mb = 0;
            f32x4 xv[4][2][2];
#pragma unroll
            for (int m = mb; m < mb + 4; ++m) { const int row = row0 + ai * 128 + m * 16;
                if (row < M_REAL) { const float* rowp = (row < ROW_META ? out + (size_t)row * D : xmeta + (size_t)(row - ROW_META) * D) + col0;
#pragma unroll
                    for (int bj = 0; bj < 2; ++bj)
#pragma unroll
                        for (int n = 0; n < 2; ++n) xv[m][bj][n] = *(const f32x4*)(rowp + bj * 128 + n * 16); } }
#pragma unroll
            for (int m = mb; m < mb + 4; ++m) { const int row = row0 + ai * 128 + m * 16;
                if (row < M_REAL) { float* rowp = (row < ROW_META ? out + (size_t)row * D : xmeta + (size_t)(row - ROW_META) * D) + col0;
#pragma unroll
                    for (int bj = 0; bj < 2; ++bj)
#pragma unroll
                        for (int n = 0; n < 2; ++n) *(f32x4*)(rowp + bj * 128 + n * 16) = xv[m][bj][n] * DN_ALPHA + acc[ai][bj][m][n]; } }
            asm volatile("" ::: "memory");
        }
    }
};

typedef MK_LAS f32x2 lf32x2;
template <int BR, int MODE>
__device__ __forceinline__ void rec_task(CArgs& a, unsigned char* ldsg, const int l, const bool sample, const int b, const int hp, const int c) {
    const int tid = otid(), hf = __builtin_amdgcn_readfirstlane(tid >> 8), tl = tid & 255, vp = tl >> 3, kq = tl & 7, h = hp * 2 + hf;
    MK_LAS unsigned char* lds = (MK_LAS unsigned char*)ldsg + hf * H_STRIDE;
    MK_LAS bf16_t* RAW = (MK_LAS bf16_t*)(lds + H_RAW); lfloat* ACT = (lfloat*)(lds + H_ACT); lfloat* OBUF = (lfloat*)(lds + H_OBUF); lfloat* SCAL = (lfloat*)(lds + H_SCAL);
    lfloat* MISC = (lfloat*)(lds + H_MISC); lfloat* CWL = (lfloat*)(lds + H_CWL); lfloat* SBUF = (lfloat*)(lds + H_RAW); lfloat* SBUF2 = SBUF + 4160; MK_LAS bf16_t* ZB = (MK_LAS bf16_t*)(lds + H_ZB);
    const bf16_t* U = (const bf16_t*)(a.ws + WS_U); const float* USM = (const float*)(a.ws + WS_USM); bf16_t* MIX = (bf16_t*)(a.ws + WS_XB);
    MK_OPQ(U); MK_OPQ(USM); MK_OPQ(MIX);
    const int nsteps = sample ? TS : CL, t0 = sample ? 0 : c * CL, bh = b * 4 + h, grp = h >> 1;
    const int NC = BR == 0 ? 512 : 768;
    const float* cw = BR == 0 ? a.in[I_SCW] + l * 4 * 512 : a.in[I_GCW] + l * 4 * 768;
    const float* cbias = BR == 0 ? a.in[I_SCB] + l * 512 : a.in[I_GCB] + l * 768;
    const float* cstate = BR == 0 ? a.in[I_SSSDC] + (size_t)(l * 128 + b) * 3 * 512 : a.in[I_SGDNC] + (size_t)(l * 128 + b) * 3 * 768;
    const int uc0 = BR == 0 ? UC_XBC + h * 64 : UC_QKV + h * 64, uc1 = BR == 0 ? UC_XBC + 256 + grp * 64 : UC_QKV + 256 + h * 64, uc2 = BR == 0 ? UC_XBC + 384 + grp * 64 : UC_QKV + 512 + h * 64;
    const int zcol = (BR == 0 ? UC_ZA : (BR == 1 ? UC_ZC : UC_ZD)) + h * 64, mixcol = (BR == 0 ? 0 : (BR == 1 ? 512 : 768)) + h * 64;
    const float* gnp = (BR == 0 ? a.in[I_SNG] : (BR == 1 ? a.in[I_GNG] : a.in[I_HNG])) + (l * 4 + h) * 64;
    const float Dh = BR == 0 ? a.in[I_SD][l * 4 + h] : 0.f;
    float* sloc = (float*)(a.ws + (BR == 0 ? WS_SS : (BR == 1 ? WS_SG : WS_SH))) + (size_t)(bh * NCH + c) * 4096;
    MK_OPQ(sloc);

    lds_barrier();
    if (BR == 2) { if (tl < 64) { const int ch = h * 64 + tl; float p[4], mx = -1e30f, sum = 0.f;
#pragma unroll
            for (int i = 0; i < 4; ++i) { p[i] = a.in[I_HLB][i * 256 + ch]; mx = fmaxf(mx, p[i]); }
#pragma unroll
            for (int i = 0; i < 4; ++i) { p[i] = __expf(p[i] - mx); sum += p[i]; }
            float lb = 0.f;
#pragma unroll
            for (int i = 1; i < 4; ++i) if (i <= l) lb += p[i];
            MISC[tl] = lb * __builtin_amdgcn_rcpf(sum); } }
    else { for (int idx = tl; idx < 5 * 192; idx += 256) { const int w = idx / 192, ch = idx - w * 192, part = ch >> 6, d = ch & 63; const int ci = (part == 0 ? uc0 : (part == 1 ? uc1 : uc2)) - (BR == 0 ? UC_XBC : UC_QKV) + d;
            CWL[idx] = w < 4 ? cw[w * NC + ci] : cbias[ci]; } }
    f32x2 S[8], T[8]; float zero_ = 0.f, one_ = 1.f; asm volatile("" : "+v"(zero_), "+v"(one_));
    if (MODE == 1) {
        const float* s_in = sample ? (BR == 0 ? a.in[I_SSSD] : (BR == 1 ? a.in[I_SGDN] : a.in[I_SHG])) + (size_t)((l * 128 + b) * 4 + h) * 4096 : sloc;
        { float tmp[16];
#pragma unroll
          for (int i = 0; i < 16; ++i) tmp[i] = sample ? __builtin_nontemporal_load(s_in + tl + i * 256) : s_in[tl + i * 256];
#pragma unroll
          for (int i = 0; i < 16; ++i) { const int idx = tl + i * 256; SBUF[(idx >> 6) * 65 + (idx & 63)] = tmp[i]; } }
        lds_barrier();
#pragma unroll
        for (int i = 0; i < 8; ++i) { S[i][0] = SBUF[(kq * 8 + i) * 65 + 2 * vp]; S[i][1] = SBUF[(kq * 8 + i) * 65 + 2 * vp + 1]; }
    } else {
#pragma unroll
        for (int i = 0; i < 8; ++i) { S[i][0] = zero_; S[i][1] = zero_;
            T[i][0] = (BR == 1) ? ((kq * 8 + i == 2 * vp) ? one_ : zero_) : one_; T[i][1] = (BR == 1) ? ((kq * 8 + i == 2 * vp + 1) ? one_ : zero_) : one_; }
    }
    float decprod = one_, tprod = one_;
    f32x4 lacc[4] = {{zero_, zero_, zero_, zero_}, {zero_, zero_, zero_, zero_}, {zero_, zero_, zero_, zero_}, {zero_, zero_, zero_, zero_}};

    for (int ts = 0; ts < nsteps; ts += ST) {
        const int n = (nsteps - ts) < ST ? (nsteps - ts) : ST;
        lds_barrier();
        if (BR == 2) {
            u32x4 ld[6];
#pragma unroll
            for (int it = 0; it < 6; ++it) { const int idx = tl + it * 256; const int s = idx >> 5, part = (idx >> 3) & 3, oct = idx & 7; ld[it] = (u32x4){0u, 0u, 0u, 0u};
                if (s < n && !(MODE == 0 && (part & 1))) { const int t = t0 + ts + s; const int row = sample ? ROW_SAMPLE + b * 4 + t : prow(b, t);
                    const int col = (part == 0 ? UC_FD : (part == 1 ? UC_QD : (part == 2 ? UC_ID : UC_ZD))) + h * 64 + oct * 8;
                    ld[it] = *(const u32x4*)(U + (size_t)row * NU + col); } }
#pragma unroll
            for (int it = 0; it < 6; ++it) { const int idx = tl + it * 256; const int s = idx >> 5, part = (idx >> 3) & 3, oct = idx & 7;
                if (s < n && !(MODE == 0 && (part & 1))) { float x[8];
#pragma unroll
                    for (int j = 0; j < 4; ++j) { x[2 * j] = __uint_as_float(ld[it][j] << 16); x[2 * j + 1] = __uint_as_float(ld[it][j] & 0xffff0000u); }
                    if (part == 0) {
#pragma unroll
                        for (int j = 0; j < 8; ++j) { const float lb = MISC[oct * 8 + j]; x[j] = lb + (1.f - lb) * sigm(x[j]); } }
                    else if (part == 1) {
#pragma unroll
                        for (int j = 0; j < 8; ++j) x[j] = silu(x[j]); }
                    if (part == 3) *(MK_LAS u32x4*)(ZB + s * 64 + oct * 8) = ld[it];
                    else { lfloat* dst = ACT + s * 256 + part * 64 + oct * 8; *(lf32x4*)dst = (f32x4){x[0], x[1], x[2], x[3]}; *(lf32x4*)(dst + 4) = (f32x4){x[4], x[5], x[6], x[7]}; } } }
            lds_barrier();
        } else {
            u32x4 ld[6]; f32x4 lf0[6], lf1[6];
#pragma unroll
            for (int it = 0; it < 6; ++it) { const int idx = tl + it * 256; const int j = idx >> 5, part = (idx >> 3) & 3, oct = idx & 7, t = t0 + ts - 3 + j;
                ld[it] = (u32x4){0u, 0u, 0u, 0u}; lf0[it] = (f32x4){0.f, 0.f, 0.f, 0.f}; lf1[it] = lf0[it];
                if (j < n + 3 && !(MODE == 0 && (part == 3 || part == (BR == 0 ? 2 : 0)))) { const int ucb = part == 0 ? uc0 : (part == 1 ? uc1 : (part == 2 ? uc2 : zcol));
                    if (t >= 0) { if (part < 3 || j >= 3) { const int row = sample ? ROW_SAMPLE + b * 4 + t : prow(b, t); ld[it] = *(const u32x4*)(U + (size_t)row * NU + ucb + oct * 8); } }
                    else if (sample && part < 3) { const float* cp = cstate + (3 + t) * NC + ucb - (BR == 0 ? UC_XBC : UC_QKV) + oct * 8; lf0[it] = *(const f32x4*)cp; lf1[it] = *(const f32x4*)(cp + 4); } } }
            if (tl < n) { const int t = t0 + ts + tl; const int row = sample ? ROW_SAMPLE + b * 4 + t : prow(b, t);
                if (BR == 0) { const float dtv = softplus(USM[(size_t)row * 16 + h] + a.in[I_SDTB][l * 4 + h]); const float aa = -dtv * __expf(a.in[I_SALOG][l * 4 + h]); SCAL[tl * 2] = __expf(aa); SCAL[tl * 2 + 1] = dtv; }
                else { const float beta = sigm(USM[(size_t)row * 16 + 4 + h]); const float g = -__expf(a.in[I_GALOG][l * 4 + h]) * softplus(USM[(size_t)row * 16 + 8 + h] + a.in[I_GDTB][l * 4 + h]); SCAL[tl * 2] = __expf(g); SCAL[tl * 2 + 1] = beta; } }
#pragma unroll
            for (int it = 0; it < 6; ++it) { const int idx = tl + it * 256; const int j = idx >> 5, part = (idx >> 3) & 3, oct = idx & 7, t = t0 + ts - 3 + j;
                if (j < n + 3 && (part < 3 || j >= 3) && !(MODE == 0 && (part == 3 || part == (BR == 0 ? 2 : 0)))) { u32x4 rw = ld[it];
                    if (t < 0) { rw.x = pk2(lf0[it][0], lf0[it][1]); rw.y = pk2(lf0[it][2], lf0[it][3]); rw.z = pk2(lf1[it][0], lf1[it][1]); rw.w = pk2(lf1[it][2], lf1[it][3]); }
                    if (part == 3) *(MK_LAS u32x4*)(ZB + (j - 3) * 64 + oct * 8) = rw; else *(MK_LAS u32x4*)(RAW + j * 192 + part * 64 + oct * 8) = rw; } }
            lds_barrier();
            constexpr int NCG = (MODE == 0) ? 32 : 48, CH0 = (MODE == 0 && BR == 1) ? 64 : 0;
            for (int idx = tl; idx < n * NCG; idx += 256) { const int s = idx / NCG, ch = CH0 + (idx - s * NCG) * 4, part = ch >> 6, d = ch & 63;
                f32x4 acc = *(const lf32x4*)(CWL + 4 * 192 + ch);
#pragma unroll
                for (int w = 0; w < 4; ++w) { const u32x2 rv = *(const MK_LAS u32x2*)(RAW + (s + w) * 192 + ch);
                    acc += *(const lf32x4*)(CWL + w * 192 + ch) * (f32x4){__uint_as_float(rv.x << 16), __uint_as_float(rv.x & 0xffff0000u), __uint_as_float(rv.y << 16), __uint_as_float(rv.y & 0xffff0000u)}; }
                acc = (f32x4){silu(acc[0]), silu(acc[1]), silu(acc[2]), silu(acc[3])};
                if (BR == 0) { if (part == 0) { *(lf32x4*)(ACT + s * 256 + 192 + d) = acc; *(lf32x4*)(ACT + s * 256 + 128 + d) = acc * SCAL[s * 2 + 1]; } else if (part == 1) *(lf32x4*)(ACT + s * 256 + d) = acc; else *(lf32x4*)(ACT + s * 256 + 64 + d) = acc; }
                else { if (part == 0) *(lf32x4*)(ACT + s * 256 + 64 + d) = acc; else if (part == 1) *(lf32x4*)(ACT + s * 256 + d) = acc; else *(lf32x4*)(ACT + s * 256 + 128 + d) = acc; } }
            lds_barrier();
            if (BR == 1) {
#pragma unroll
                for (int pass = 0; pass < 3; ++pass) { const int r = pass * 32 + vp;
                    if (r < (MODE == 0 ? n : 2 * n)) { const int s = MODE == 0 ? r : (r >> 1), isq = MODE == 0 ? 0 : (r & 1); lfloat* p = ACT + s * 256 + (isq ? 64 : 0) + kq * 8; const f32x4 x0 = *(lf32x4*)p, x1 = *(lf32x4*)(p + 4);
                        float ss = (x0[0] * x0[0] + x0[1] * x0[1]) + (x0[2] * x0[2] + x0[3] * x0[3]) + (x1[0] * x1[0] + x1[1] * x1[1]) + (x1[2] * x1[2] + x1[3] * x1[3]);
                        ss = red8(ss); const float sc = __builtin_amdgcn_rsqf(ss + L2_EPS) * (isq ? 0.125f : 1.f);
                        *(lf32x4*)p = x0 * sc; *(lf32x4*)(p + 4) = x1 * sc; }
                    else { (void)red8(0.f); } }
                lds_barrier(); }
        }
        if (MODE == 0 && BR != 1) {
            const int lane = tid & 63, kt = (tl >> 6), n4 = (n + 3) & ~3;
            if (BR == 0) { if (tl == 0) { float dv[ST];
#pragma unroll
                    for (int s = 0; s < ST; ++s) dv[s] = s < n ? SCAL[s * 2] : one_;
                    float run = one_;
#pragma unroll
                    for (int s = ST - 1; s >= 0; --s) { if (s < n) SCAL[s * 2 + 1] = run; run *= dv[s]; }
                    SCAL[2 * ST] = run; } }
            else { if (tl < 64) { float fv[ST];
#pragma unroll
                    for (int s = 0; s < ST; ++s) fv[s] = s < n ? ACT[s * 256 + tl] : one_;
                    float run = one_;
#pragma unroll
                    for (int s = ST - 1; s >= 0; --s) { if (s < n) ACT[s * 256 + tl] = (1.f - fv[s]) * run; run *= fv[s]; }
                    CWL[tl] = run; tprod *= run; } }
            for (int idx = tl; idx < (n4 - n) * 64; idx += 256) { const int s = n + (idx >> 6), d = idx & 63; ACT[s * 256 + d] = 0.f; ACT[s * 256 + 128 + d] = 0.f; }
            lds_barrier();
            if (BR == 0) { const float Dt = SCAL[2 * ST]; decprod *= Dt;
#pragma unroll
                for (int vt = 0; vt < 4; ++vt) lacc[vt] = lacc[vt] * Dt; }
            else {
#pragma unroll
                for (int r = 0; r < 4; ++r) { const float dk = CWL[kt * 16 + 4 * (lane >> 4) + r];
#pragma unroll
                    for (int vt = 0; vt < 4; ++vt) lacc[vt][r] *= dk; } }
            for (int s0 = 0; s0 < n4; s0 += 4) { const int sr = s0 + (lane >> 4); const lfloat* rp = ACT + sr * 256 + (lane & 15); float av = rp[kt * 16];
                if (BR == 0) av *= (sr < n ? SCAL[sr * 2 + 1] : 0.f);
#pragma unroll
                for (int vt = 0; vt < 4; ++vt) lacc[vt] = __builtin_amdgcn_mfma_f32_16x16x4f32(av, rp[128 + vt * 16], lacc[vt], 0, 0, 0); }
        } else
#define REC_BODY(a0, a1, b0, b1, vv, sc0, sc1, s) do { \
    const float A[8] = {a0[0], a0[1], a0[2], a0[3], a1[0], a1[1], a1[2], a1[3]}; \
    const float Bq[8] = {b0[0], b0[1], b0[2], b0[3], b1[0], b1[1], b1[2], b1[3]}; \
    if (BR == 0) { \
    if (MODE == 0) { decprod *= sc0; \
    _Pragma("unroll") \
    for (int i = 0; i < 8; ++i) S[i] = S[i] * sc0 + vv * A[i]; \
    } else { f32x2 ya = {0.f, 0.f}; \
    _Pragma("unroll") \
    for (int i = 0; i < 8; ++i) { S[i] = S[i] * sc0 + vv * A[i]; ya += S[i] * Bq[i]; } \
    f32x2 y; y[0] = red8(ya[0]); y[1] = red8(ya[1]); if (kq == 0) *(lf32x2*)(OBUF + s * 64 + 2 * vp) = y; } \
    } else if (BR == 1) { \
    if (MODE == 0) { f32x2 ra = {0.f, 0.f}, rp = {0.f, 0.f}; \
    _Pragma("unroll") \
    for (int i = 0; i < 8; ++i) { S[i] *= sc0; T[i] *= sc0; ra += S[i] * A[i]; rp += T[i] * A[i]; } \
    f32x2 r, rpp; r[0] = red8(ra[0]); r[1] = red8(ra[1]); rpp[0] = red8(rp[0]); rpp[1] = red8(rp[1]); \
    const f32x2 vn = (vv - r) * sc1, vnp = rpp * (-sc1); \
    _Pragma("unroll") \
    for (int i = 0; i < 8; ++i) { S[i] += vn * A[i]; T[i] += vnp * A[i]; } \
    } else { f32x2 ra = {0.f, 0.f}; \
    _Pragma("unroll") \
    for (int i = 0; i < 8; ++i) { S[i] *= sc0; ra += S[i] * A[i]; } \
    f32x2 r; r[0] = red8(ra[0]); r[1] = red8(ra[1]); \
    const f32x2 vn = (vv - r) * sc1; f32x2 oa = {0.f, 0.f}; \
    _Pragma("unroll") \
    for (int i = 0; i < 8; ++i) { S[i] += vn * A[i]; oa += S[i] * Bq[i]; } \
    f32x2 o; o[0] = red8(oa[0]); o[1] = red8(oa[1]); if (kq == 0) *(lf32x2*)(OBUF + s * 64 + 2 * vp) = o; } \
    } else { \
    if (MODE == 0) { \
    _Pragma("unroll") \
    for (int i = 0; i < 8; ++i) { S[i] = S[i] * A[i] + vv * (1.f - A[i]); T[i] *= A[i]; } \
    } else { f32x2 oa = {0.f, 0.f}; \
    _Pragma("unroll") \
    for (int i = 0; i < 8; ++i) { S[i] = S[i] * A[i] + vv * (1.f - A[i]); oa += S[i] * Bq[i]; } \
    f32x2 o; o[0] = red8(oa[0]); o[1] = red8(oa[1]); if (kq == 0) *(lf32x2*)(OBUF + s * 64 + 2 * vp) = o; } \
    } \
    } while (0)
#define REC_FETCH(a0, a1, b0, b1, vv, sc0, sc1, SI) do { const int si_ = (SI); const lfloat* an_ = ACT + si_ * 256 + kq * 8; \
    a0 = *(const lf32x4*)(an_); a1 = *(const lf32x4*)(an_ + 4); if (MODE == 1) { b0 = *(const lf32x4*)(an_ + 64); b1 = *(const lf32x4*)(an_ + 68); } \
    vv = *(const lf32x2*)(ACT + si_ * 256 + 128 + 2 * vp); sc0 = (BR != 2) ? SCAL[si_ * 2] : 0.f; sc1 = (BR == 1) ? SCAL[si_ * 2 + 1] : 0.f; } while (0)
        if (MODE == 0)
        {
            const lfloat* ar = ACT + kq * 8;
            f32x4 a0 = *(const lf32x4*)(ar), a1 = *(const lf32x4*)(ar + 4), b0 = *(const lf32x4*)(ar + 64), b1 = *(const lf32x4*)(ar + 68);
            f32x2 vv = *(const lf32x2*)(ACT + 128 + 2 * vp); float sc0 = (BR != 2) ? SCAL[0] : 0.f, sc1 = (BR == 1) ? SCAL[1] : 0.f;
#pragma unroll 2
            for (int s = 0; s < n; ++s) {
                const int sn = (s + 1 < n) ? s + 1 : s;
                const lfloat* an = ACT + sn * 256 + kq * 8;
                const f32x4 na0 = *(const lf32x4*)(an), na1 = *(const lf32x4*)(an + 4);
                f32x4 nb0 = b0, nb1 = b1;
                if (MODE == 1) { nb0 = *(const lf32x4*)(an + 64); nb1 = *(const lf32x4*)(an + 68); }
                const f32x2 nvv = *(const lf32x2*)(ACT + sn * 256 + 128 + 2 * vp); const float nsc0 = (BR != 2) ? SCAL[sn * 2] : 0.f, nsc1 = (BR == 1) ? SCAL[sn * 2 + 1] : 0.f;
                const float A[8] = {a0[0], a0[1], a0[2], a0[3], a1[0], a1[1], a1[2], a1[3]};
                const float Bq[8] = {b0[0], b0[1], b0[2], b0[3], b1[0], b1[1], b1[2], b1[3]};
                if (BR == 0) {
                    if (MODE == 0) { decprod *= sc0;
#pragma unroll
                        for (int i = 0; i < 8; ++i) S[i] = S[i] * sc0 + vv * A[i];
                    } else { f32x2 ya = {0.f, 0.f};
#pragma unroll
                        for (int i = 0; i < 8; ++i) { S[i] = S[i] * sc0 + vv * A[i]; ya += S[i] * Bq[i]; }
                        f32x2 y; y[0] = red8(ya[0]); y[1] = red8(ya[1]); if (kq == 0) *(lf32x2*)(OBUF + s * 64 + 2 * vp) = y; }
                } else if (BR == 1) {
                    if (MODE == 0) { f32x2 ra = {0.f, 0.f}, rp = {0.f, 0.f};
#pragma unroll
                        for (int i = 0; i < 8; ++i) { S[i] *= sc0; T[i] *= sc0; ra += S[i] * A[i]; rp += T[i] * A[i]; }
                        f32x2 r, rpp; r[0] = red8(ra[0]); r[1] = red8(ra[1]); rpp[0] = red8(rp[0]); rpp[1] = red8(rp[1]);
                        const f32x2 vn = (vv - r) * sc1, vnp = rpp * (-sc1);
#pragma unroll
                        for (int i = 0; i < 8; ++i) { S[i] += vn * A[i]; T[i] += vnp * A[i]; }
                    } else { f32x2 ra = {0.f, 0.f};
#pragma unroll
                        for (int i = 0; i < 8; ++i) { S[i] *= sc0; ra += S[i] * A[i]; }
                        f32x2 r; r[0] = red8(ra[0]); r[1] = red8(ra[1]);
                        const f32x2 vn = (vv - r) * sc1; f32x2 oa = {0.f, 0.f};
#pragma unroll
                        for (int i = 0; i < 8; ++i) { S[i] += vn * A[i]; oa += S[i] * Bq[i]; }
                        f32x2 o; o[0] = red8(oa[0]); o[1] = red8(oa[1]); if (kq == 0) *(lf32x2*)(OBUF + s * 64 + 2 * vp) = o; }
                } else {
                    if (MODE == 0) {
#pragma unroll
                        for (int i = 0; i < 8; ++i) { S[i] = S[i] * A[i] + vv * (1.f - A[i]); T[i] *= A[i]; }
                    } else { f32x2 oa = {0.f, 0.f};
#pragma unroll
                        for (int i = 0; i < 8; ++i) { S[i] = S[i] * A[i] + vv * (1.f - A[i]); oa += S[i] * Bq[i]; }
                        f32x2 o; o[0] = red8(oa[0]); o[1] = red8(oa[1]); if (kq == 0) *(lf32x2*)(OBUF + s * 64 + 2 * vp) = o; }
                }
                a0 = na0; a1 = na1; b0 = nb0; b1 = nb1; vv = nvv; sc0 = nsc0; sc1 = nsc1;
            }
        }
        else
        {
            f32x4 pa0, pa1, pb0, pb1, qa0, qa1, qb0, qb1; pb0 = pb1 = qb0 = qb1 = pa0 = pa1 = qa0 = qa1 = (f32x4){zero_, zero_, zero_, zero_}; f32x2 pvv, qvv; float psc0, psc1, qsc0, qsc1;
            REC_FETCH(pa0, pa1, pb0, pb1, pvv, psc0, psc1, 0);
#pragma nounroll
            for (int s = 0; s < n; s += 2) {
                REC_FETCH(qa0, qa1, qb0, qb1, qvv, qsc0, qsc1, (s + 1 < n) ? s + 1 : s);
                REC_BODY(pa0, pa1, pb0, pb1, pvv, psc0, psc1, s);
                if (s + 1 < n) {
                    REC_FETCH(pa0, pa1, pb0, pb1, pvv, psc0, psc1, (s + 2 < n) ? s + 2 : s + 1);
                    REC_BODY(qa0, qa1, qb0, qb1, qvv, qsc0, qsc1, (s + 1));
                }
            }
        }
#undef REC_BODY
#undef REC_FETCH
        if (MODE == 1) {
            lds_barrier();
#pragma unroll
            for (int pass = 0; pass < 2; ++pass) {
                const int sidx = pass * 32 + vp; float ss = 0.f; float o[8];
                if (sidx < n) { const f32x4 o0 = *(const lf32x4*)(OBUF + sidx * 64 + kq * 8), o1 = *(const lf32x4*)(OBUF + sidx * 64 + kq * 8 + 4);
                    o[0] = o0[0]; o[1] = o0[1]; o[2] = o0[2]; o[3] = o0[3]; o[4] = o1[0]; o[5] = o1[1]; o[6] = o1[2]; o[7] = o1[3];
                    if (BR == 0) {
#pragma unroll
                        for (int i = 0; i < 8; ++i) o[i] += Dh * ACT[sidx * 256 + 192 + kq * 8 + i]; }
#pragma unroll
                    for (int i = 0; i < 8; ++i) ss += o[i] * o[i]; }
                ss = red8(ss);
                if (sidx < n) { const int t = t0 + ts + sidx; const int row = sample ? ROW_SAMPLE + b * 4 + t : prow(b, t);
                    const float r = __builtin_amdgcn_rsqf(ss * (1.f / 64.f) + RMS_EPS);
                    const f32x4 g0 = *(const f32x4*)(gnp + kq * 8), g1 = *(const f32x4*)(gnp + kq * 8 + 4);
                    const u32x4 zw = *(const MK_LAS u32x4*)(ZB + sidx * 64 + kq * 8);
                    const float z[8] = {__uint_as_float(zw.x << 16), __uint_as_float(zw.x & 0xffff0000u), __uint_as_float(zw.y << 16), __uint_as_float(zw.y & 0xffff0000u),
                                        __uint_as_float(zw.z << 16), __uint_as_float(zw.z & 0xffff0000u), __uint_as_float(zw.w << 16), __uint_as_float(zw.w & 0xffff0000u)};
                    u32x4 w; w.x = pk2(o[0] * r * g0[0] * silu(z[0]), o[1] * r * g0[1] * silu(z[1])); w.y = pk2(o[2] * r * g0[2] * silu(z[2]), o[3] * r * g0[3] * silu(z[3]));
                    w.z = pk2(o[4] * r * g1[0] * silu(z[4]), o[5] * r * g1[1] * silu(z[5])); w.w = pk2(o[6] * r * g1[2] * silu(z[6]), o[7] * r * g1[3] * silu(z[7]));
                    *(u32x4*)(MIX + (size_t)row * 1024 + mixcol + kq * 8) = w; }
            }
        }
    }
    if (MODE == 0 && BR != 1) {
        const int lane = tid & 63, kt = (tl >> 6);
#pragma unroll
        for (int vt = 0; vt < 4; ++vt)
#pragma unroll
            for (int r = 0; r < 4; ++r) sloc[(kt * 16 + 4 * (lane >> 4) + r) * 64 + vt * 16 + (lane & 15)] = lacc[vt][r];
        if (BR == 0 && tl == 0) ((float*)(a.ws + WS_DS))[bh * NCH + c] = decprod;
        if (BR == 2 && tl < 64) ((float*)(a.ws + WS_DH))[(bh * NCH + c) * 64 + tl] = tprod;
    } else
    if (MODE == 0 || sample) {
        float* dst = MODE == 0 ? sloc : a.out + (BR == 0 ? O_SSSD : (BR == 1 ? O_SGDN : O_SHG)) + (size_t)((l * 128 + b) * 4 + h) * 4096;
        lds_barrier();
#pragma unroll
        for (int i = 0; i < 8; ++i) { SBUF[(kq * 8 + i) * 65 + 2 * vp] = S[i][0]; SBUF[(kq * 8 + i) * 65 + 2 * vp + 1] = S[i][1]; }
        if (MODE == 0 && BR == 1) {
#pragma unroll
            for (int i = 0; i < 8; ++i) { SBUF2[(kq * 8 + i) * 65 + 2 * vp] = T[i][0]; SBUF2[(kq * 8 + i) * 65 + 2 * vp + 1] = T[i][1]; } }
        lds_barrier();
        for (int idx = tl; idx < 4096; idx += 256) { const float sv = SBUF[(idx >> 6) * 65 + (idx & 63)]; if (MODE == 1) __builtin_nontemporal_store(sv, dst + idx); else dst[idx] = sv; }
        if (MODE == 0 && BR == 1) { float* pd = (float*)(a.ws + WS_PG) + (size_t)(bh * NCH + c) * 4096; for (int idx = tl; idx < 4096; idx += 256) pd[idx] = SBUF2[(idx >> 6) * 65 + (idx & 63)]; }
        if (MODE == 0 && BR == 0 && tl == 0) ((float*)(a.ws + WS_DS))[bh * NCH + c] = decprod;
        if (MODE == 0 && BR == 2 && vp == 0) {
#pragma unroll
            for (int i = 0; i < 8; ++i) ((float*)(a.ws + WS_DH))[(bh * NCH + c) * 64 + kq * 8 + i] = T[i][0]; }
    }
}

constexpr int L5_CRE = 0, L5_CIM = 4352, L5_UB = 8704, L5_HB = 16896;
static_assert(L5_HB + 8 * 16 * 132 * 4 <= 131072, "lds5");
template <int MODE>
__device__ __forceinline__ void s5_task(CArgs& a, unsigned char* ldsg, const int l, const bool sample, const int g, const int c) {
    MK_LAS unsigned char* lds = (MK_LAS unsigned char*)ldsg;
    lfloat* CRE = (lfloat*)(lds + L5_CRE); lfloat* CIM = (lfloat*)(lds + L5_CIM);
    const int tid = otid(), lane = tid & 63, wave = tid >> 6;
    lfloat* UB = (lfloat*)(lds + L5_UB) + wave * 256; MK_LAS bf16_t* HB = (MK_LAS bf16_t*)(lds + L5_HB) + wave * 16 * 136;
    const bf16_t* U = (const bf16_t*)(a.ws + WS_U); bf16_t* Y5 = (bf16_t*)(a.ws + WS_Y5);
    MK_OPQ(U); MK_OPQ(Y5);
    const int b = sample ? c * 8 + wave : wave, nsteps = sample ? TS : CL, t0 = sample ? 0 : c * CL, lg = l * 16 + g;
    const float dt = __expf(a.in[I_LOGDT][lg]); const float lr = a.in[I_LAMR][lg * 64 + lane], li = a.in[I_LAMI][lg * 64 + lane];
    const float mag = __expf(lr * dt); float sn, cs; { float rv = li * dt * 0.15915494309189535f; rv -= rintf(rv); sn = __builtin_amdgcn_sinf(rv); cs = __builtin_amdgcn_cosf(rv); }
    const float lbr = mag * cs, lbi = mag * sn, den = lr * lr + li * li, nr = lbr - 1.f;
    const float rden = __builtin_amdgcn_rcpf(den); const float cr = (nr * lr + lbi * li) * rden, ci = (lbi * lr - nr * li) * rden;
    float bbr[16], bbi[16];
    { const f32x4* pr = (const f32x4*)(a.in[I_BR] + (size_t)(lg * 64 + lane) * 16); const f32x4* pi = (const f32x4*)(a.in[I_BI] + (size_t)(lg * 64 + lane) * 16);
#pragma unroll
        for (int j = 0; j < 4; ++j) { const f32x4 r = pr[j], im = pi[j];
#pragma unroll
            for (int k = 0; k < 4; ++k) { bbr[j * 4 + k] = cr * r[k] - ci * im[k]; bbi[j * 4 + k] = cr * im[k] + ci * r[k]; } } }
    __syncthreads();
    pg8::bf16x8 cfrag[4];
    if (MODE == 1) {
#pragma unroll
        for (int kb = 0; kb < 4; ++kb)
#pragma unroll
            for (int j = 0; j < 8; ++j) { const int k = (kb & 1) * 32 + (lane >> 4) * 8 + j;
                const float cv = kb < 2 ? a.in[I_CR][(size_t)lg * 1024 + (lane & 15) * 64 + k] : -a.in[I_CI][(size_t)lg * 1024 + (lane & 15) * 64 + k];
                cfrag[kb][j] = (short)f2bf(cv); } }
    float* h5 = (float*)(a.ws + WS_H5) + (size_t)((b * 16 + g) * NCH + c) * 128;
    float hr = 0.f, hi = 0.f;
    if (MODE == 1) { if (sample) { hr = a.in[I_SS5R][(size_t)((l * 128 + b) * 16 + g) * 64 + lane]; hi = a.in[I_SS5I][(size_t)((l * 128 + b) * 16 + g) * 64 + lane]; } else { hr = h5[lane]; hi = h5[64 + lane]; } }
    __syncthreads();
    const int tt = lane >> 2, qq = lane & 3;
    float dq = 0.f;
    if (MODE == 1) dq = a.in[I_S5D][lg * 16 + (lane & 15)];
    for (int ts = 0; ts < nsteps; ts += 16) {
        const int n = (nsteps - ts) < 16 ? (nsteps - ts) : 16;
        { f32x4 uv = {0.f, 0.f, 0.f, 0.f};
          if (tt < n) { const int t = t0 + ts + tt; const int row = sample ? ROW_SAMPLE + b * 4 + t : prow(b, t); const u32x2 w = *(const u32x2*)(U + (size_t)row * NU + UC_UB + g * 16 + qq * 4);
              uv[0] = __uint_as_float(w.x << 16); uv[1] = __uint_as_float(w.x & 0xffff0000u); uv[2] = __uint_as_float(w.y << 16); uv[3] = __uint_as_float(w.y & 0xffff0000u); }
          *(lf32x4*)(UB + tt * 16 + qq * 4) = uv; }
        __builtin_amdgcn_wave_barrier(); asm volatile("s_waitcnt lgkmcnt(0)" ::: "memory");
        for (int s = 0; s < n; ++s) {
            float bur = 0.f, bui = 0.f;
#pragma unroll
            for (int j = 0; j < 4; ++j) { const f32x4 uu = *(const lf32x4*)(UB + s * 16 + j * 4);
#pragma unroll
                for (int k = 0; k < 4; ++k) { bur += bbr[j * 4 + k] * uu[k]; bui += bbi[j * 4 + k] * uu[k]; } }
            const float nhr = lbr * hr - lbi * hi + bur, nhi = lbr * hi + lbi * hr + bui; hr = nhr; hi = nhi;
            if (MODE == 1) { HB[s * 136 + lane] = f2bf(hr); HB[s * 136 + 64 + lane] = f2bf(hi); }
        }
        if (MODE == 1) {
            __builtin_amdgcn_wave_barrier(); asm volatile("s_waitcnt lgkmcnt(0)" ::: "memory");
            {
                f32x4 d = {0.f, 0.f, 0.f, 0.f};
#pragma unroll
                for (int kb = 0; kb < 4; ++kb) { const pg8::bf16x8 af = *(const MK_LAS pg8::bf16x8*)(HB + (lane & 15) * 136 + kb * 32 + (lane >> 4) * 8);
                    d = __builtin_amdgcn_mfma_f32_16x16x32_bf16(af, cfrag[kb], d, 0, 0, 0); }
                const int q = lane & 15;
#pragma unroll
                for (int r = 0; r < 4; ++r) { const int st = 4 * (lane >> 4) + r;
                    if (st < n) { const int t = t0 + ts + st; const int row = sample ? ROW_SAMPLE + b * 4 + t : prow(b, t);
                        Y5[(size_t)row * 256 + g * 16 + q] = f2bf(gelu_tanh(d[r] + dq * UB[st * 16 + q])); } }
            }
            __builtin_amdgcn_wave_barrier(); asm volatile("s_waitcnt lgkmcnt(0)" ::: "memory");
        }
    }
    if (MODE == 0) { h5[lane] = hr; h5[64 + lane] = hi; }
    else if (sample) { a.out[O_SS5R + (size_t)((l * 128 + b) * 16 + g) * 64 + lane] = hr; a.out[O_SS5I + (size_t)((l * 128 + b) * 16 + g) * 64 + lane] = hi; }
}

__device__ __forceinline__ void conv_copy_task(CArgs& a, int l, int part, int nparts) {
    const bf16_t* U = (const bf16_t*)(a.ws + WS_U); MK_OPQ(U);
    const int tid = otid();
    for (int unit = part; unit < 136 * 3; unit += nparts) {
        const int sb = unit / 3, j = unit - sb * 3; const bool smp = sb >= 8; const int b = smp ? sb - 8 : sb;
        const int row = smp ? ROW_SAMPLE + b * 4 + 1 + j : prow(b, TP - 3 + j);
        const bf16_t* ur = U + (size_t)row * NU;
        float* o1 = a.out + (smp ? O_SSSDC + (size_t)(l * 128 + b) * SZ_SC : O_PSSDC + (size_t)(l * 8 + b) * SZ_SC) + j * 512;
        float* o2 = a.out + (smp ? O_SGDNC + (size_t)(l * 128 + b) * SZ_GC : O_PGDNC + (size_t)(l * 8 + b) * SZ_GC) + j * 768;
        MK_OPQ(ur); MK_OPQ(o1); MK_OPQ(o2);
        for (int ch = tid; ch < 1280; ch += 512) { if (ch < 512) o1[ch] = bf2f(ur[UC_XBC + ch]); else o2[ch - 512] = bf2f(ur[UC_QKV + ch - 512]); }
    }
}

__device__ __forceinline__ void pass2_gdn(CArgs& a, unsigned char* ldsg, int l, int bh, int vb) {
    MK_LAS unsigned char* lds = (MK_LAS unsigned char*)ldsg;
    lfloat* PL = (lfloat*)lds; lfloat* SL = (lfloat*)(lds + 64 * 68 * 4);
    const int tid = otid(), k = tid >> 3, vv = tid & 7;
    float* sg = (float*)(a.ws + WS_SG) + (size_t)bh * NCH * 4096; const float* pg = (const float*)(a.ws + WS_PG) + (size_t)bh * NCH * 4096;
    MK_OPQ(sg); MK_OPQ(pg);
    lds_barrier();
    float cur = 0.f; asm volatile("" : "+v"(cur));
    SL[k * 8 + vv] = cur;
    f32x4 p0 = *(const f32x4*)(pg + tid * 8), p1 = *(const f32x4*)(pg + tid * 8 + 4);
    float lval = sg[k * 64 + vb * 8 + vv];
    for (int c = 0; c < NCH; ++c) {
        { const int r = tid >> 3, cc = (tid & 7) * 8; *(lf32x4*)(PL + r * 68 + cc) = p0; *(lf32x4*)(PL + r * 68 + cc + 4) = p1; }
        float* slot = sg + (size_t)c * 4096 + k * 64 + vb * 8 + vv;
        float acc = lval;
        if (c + 1 < NCH) { const float* pc = pg + (size_t)(c + 1) * 4096; p0 = *(const f32x4*)(pc + tid * 8); p1 = *(const f32x4*)(pc + tid * 8 + 4); lval = slot[4096]; }
        lds_barrier();
#pragma unroll 4
        for (int j4 = 0; j4 < 16; ++j4) { const f32x4 p = *(const lf32x4*)(PL + k * 68 + j4 * 4);
#pragma unroll
            for (int q = 0; q < 4; ++q) acc += p[q] * SL[(j4 * 4 + q) * 8 + vv]; }
        *slot = cur;
        lds_barrier();
        cur = acc; SL[k * 8 + vv] = acc;
    }
    const int b = bh >> 2, h = bh & 3;
    a.out[O_PGDN + (size_t)((l * 8 + b) * 4 + h) * 4096 + k * 64 + vb * 8 + vv] = cur;
}
__device__ __forceinline__ void pass2_diag(CArgs& a, int l, int br  , int bh, int quarter) {
    float* ss = (float*)(a.ws + (br == 0 ? WS_SS : WS_SH)) + (size_t)bh * NCH * 4096;
    const float* ds = (const float*)(a.ws + WS_DS) + bh * NCH; const float* dh = (const float*)(a.ws + WS_DH) + (size_t)bh * NCH * 64;
    MK_OPQ(ss); MK_OPQ(ds); MK_OPQ(dh);
    const int e = quarter * 1024 + otid() * 2, k = e >> 6;
    f32x2 lv[NCH]; float dc[NCH];
#pragma unroll
    for (int c = 0; c < NCH; ++c) { lv[c] = *(const f32x2*)(ss + (size_t)c * 4096 + e); dc[c] = br == 0 ? ds[c] : dh[c * 64 + k]; }
    float c0 = 0.f, c1 = 0.f; asm volatile("" : "+v"(c0), "+v"(c1));
#pragma unroll
    for (int c = 0; c < NCH; ++c) { *(f32x2*)(ss + (size_t)c * 4096 + e) = (f32x2){c0, c1}; c0 = dc[c] * c0 + lv[c][0]; c1 = dc[c] * c1 + lv[c][1]; }
    const int b = bh >> 2, h = bh & 3; float* o = a.out + (br == 0 ? O_PSSD : O_PHG) + (size_t)((l * 8 + b) * 4 + h) * 4096 + e;
    o[0] = c0; o[1] = c1;
}
__device__ __forceinline__ void pass2_s5(CArgs& a, int l, int part) {
    const int e = part * 512 + otid(), bg = e >> 6, n = e & 63, b = bg >> 4, g = bg & 15, lg = l * 16 + g;
    const float dt = __expf(a.in[I_LOGDT][lg]); const float lr = a.in[I_LAMR][lg * 64 + n], li = a.in[I_LAMI][lg * 64 + n];
    const float mag = __expf(lr * dt); float sn, cs; { float rv = li * dt * 0.15915494309189535f; rv -= rintf(rv); sn = __builtin_amdgcn_sinf(rv); cs = __builtin_amdgcn_cosf(rv); }
    const float lbr = mag * cs, lbi = mag * sn;
    float pr = 1.f, pi = 0.f;
    for (int i = 0; i < CL; ++i) { const float t = pr * lbr - pi * lbi; pi = pr * lbi + pi * lbr; pr = t; }
    float* h5 = (float*)(a.ws + WS_H5) + (size_t)bg * NCH * 128;
    float hr = 0.f, hi = 0.f; asm volatile("" : "+v"(hr), "+v"(hi));
    float l0v[NCH], l1v[NCH];
#pragma unroll
    for (int c = 0; c < NCH; ++c) { l0v[c] = h5[c * 128 + n]; l1v[c] = h5[c * 128 + 64 + n]; }
#pragma unroll
    for (int c = 0; c < NCH; ++c) { float* s = h5 + c * 128; s[n] = hr; s[64 + n] = hi;
        const float t = pr * hr - pi * hi + l0v[c]; hi = pr * hi + pi * hr + l1v[c]; hr = t; }
    a.out[O_PS5R + (size_t)((l * 8 + b) * 16 + g) * 64 + n] = hr; a.out[O_PS5I + (size_t)((l * 8 + b) * 16 + g) * 64 + n] = hi;
}

#define XB_TMO      128
#define XB_XCNT(j)  (256  + 64 * (j))
#define XB_XSUB(j)  (1280 + 64 * (j))
#define XB_XGEN(j)  (2304 + 64 * (j))
#define XB_TOP      3328
#define XB_TOPGEN   3392
#define XCD_BAR_WORDS 3456
#define XB_SPIN_CAP (1u << 18)

__device__ __forceinline__ unsigned xb_ld(unsigned* p)              { return __hip_atomic_load(p, __ATOMIC_RELAXED, __HIP_MEMORY_SCOPE_AGENT); }
__device__ __forceinline__ unsigned xb_add(unsigned* p, unsigned v) { return __hip_atomic_fetch_add(p, v, __ATOMIC_RELAXED, __HIP_MEMORY_SCOPE_AGENT); }
__device__ __forceinline__ unsigned xb_xcc_id() { return (unsigned)__builtin_amdgcn_s_getreg((3 << 11) | 20) & 0xFu; }
#define XB_SPIN(cond, bar) do { unsigned _sp = 0; while (cond) { __builtin_amdgcn_s_sleep(1); \
    if ((++_sp & 255u) == 0u) { if (xb_ld(&(bar)[XB_TMO])) break; if (_sp > XB_SPIN_CAP) { atomicAdd(&(bar)[XB_TMO], 1u); break; } } } } while (0)

struct XcdBarrier {
    unsigned* bar; unsigned x;
    volatile MK_LAS unsigned* st;
};

__device__ __forceinline__ XcdBarrier xcd_barrier_post(unsigned* bar, volatile MK_LAS unsigned* st) {
    XcdBarrier b; b.bar = bar; b.x = xb_xcc_id(); b.st = st;
    if (threadIdx.x == 0) (void)xb_add(&bar[XB_XCNT(b.x)], 1u);
    return b;
}
__device__ __forceinline__ void xcd_barrier_complete(unsigned* bar, unsigned x, unsigned& nloc, unsigned& nx) {
    const unsigned G = gridDim.x * gridDim.y * gridDim.z;
    unsigned sum, cnt, mine, sp = 0u;
    for (;;) {
        sum = 0u; cnt = 0u; mine = 0u;
#pragma unroll
        for (unsigned j = 0; j < 16; ++j) { const unsigned c = xb_ld(&bar[XB_XCNT(j)]); sum += c; cnt += (c > 0u) ? 1u : 0u; mine = (j == x) ? c : mine; }
        if (sum == G) break;
        __builtin_amdgcn_s_sleep(1);
        if ((++sp & 255u) == 0u) { if (xb_ld(&bar[XB_TMO])) break; if (sp > XB_SPIN_CAP) { atomicAdd(&bar[XB_TMO], 1u); break; } }
    }
    nloc = mine > 0u ? mine : 1u; nx = cnt > 0u ? cnt : 1u;
}

__device__ __forceinline__ void xcd_barrier(const XcdBarrier& b) {
    asm volatile("s_waitcnt vmcnt(0)" ::: "memory");
    __syncthreads();
    if (threadIdx.x == 0) {
        unsigned* bar = b.bar;
        __builtin_amdgcn_s_waitcnt(0);
        unsigned nloc = b.st[0], nx = b.st[1];
        if (nloc == 0u) { xcd_barrier_complete(bar, b.x, nloc, nx); b.st[0] = nloc; b.st[1] = nx; }
        const unsigned old = xb_add(&bar[XB_XSUB(b.x)], 1u);
        const unsigned gen = old / nloc;
        if (old + 1u == (gen + 1u) * nloc) {
            __builtin_amdgcn_fence(__ATOMIC_RELEASE, "agent");
            asm volatile("s_waitcnt vmcnt(0)" ::: "memory");
            const unsigned og = xb_add(&bar[XB_TOP], 1u);
            const unsigned tg = og / nx;
            if (og + 1u == (tg + 1u) * nx) xb_add(&bar[XB_TOPGEN], 1u);
            else XB_SPIN(xb_ld(&bar[XB_TOPGEN]) == tg, bar);
            __builtin_amdgcn_fence(__ATOMIC_ACQUIRE, "agent");
            xb_add(&bar[XB_XGEN(b.x)], 1u);
            asm volatile("s_waitcnt vmcnt(0)" ::: "memory");
        } else {
            XB_SPIN(xb_ld(&bar[XB_XGEN(b.x)]) == gen, bar);
            __builtin_amdgcn_fence(__ATOMIC_ACQUIRE, "agent");
            asm volatile("s_waitcnt vmcnt(0)" ::: "memory");
        }
    }
    __syncthreads();
}

__device__ __forceinline__ void phase_mixer(CArgs& a, unsigned char* lds, int l, int which  ) {
    const int ntasks = which == 1 ? 2304 : 1024;
    for (int task = obid(); task < ntasks; task += gridDim.x) {
        int kind, p0, p1; bool sample = false;
        if (which == 1) {
            if (task < 768) { kind = task >> 8; p0 = (task & 255) >> 4; p1 = task & 15; }
            else if (task < 1024) { kind = 3; p0 = (task - 768) >> 4; p1 = task & 15; }
            else if (task < 1792) { const int r = task - 1024; kind = 4 + (r >> 8); p0 = r & 255; p1 = 0; sample = true; }
            else if (task < 2048) { const int r = task - 1792; kind = 7; p0 = r >> 4; p1 = r & 15; sample = true; }
            else { kind = 8; p0 = task - 2048; p1 = 0; }
        } else {
            if (task < 768) { kind = 4 + (task >> 8); p0 = (task & 255) >> 4; p1 = task & 15; }
            else { kind = 7; p0 = (task - 768) >> 4; p1 = task & 15; }
        }
        switch (kind) {
            case 0: rec_task<1, 0>(a, lds, l, false, p0 >> 1, p0 & 1, p1); break;
            case 1: rec_task<0, 0>(a, lds, l, false, p0 >> 1, p0 & 1, p1); break;
            case 2: rec_task<2, 0>(a, lds, l, false, p0 >> 1, p0 & 1, p1); break;
            case 3: s5_task<0>(a, lds, l, false, p0, p1); break;
            case 4: rec_task<1, 1>(a, lds, l, sample, p0 >> 1, p0 & 1, p1); break;
            case 5: rec_task<0, 1>(a, lds, l, sample, p0 >> 1, p0 & 1, p1); break;
            case 6: rec_task<2, 1>(a, lds, l, sample, p0 >> 1, p0 & 1, p1); break;
            case 7: s5_task<1>(a, lds, l, sample, p0, p1); break;
            default: conv_copy_task(a, l, p0, 256); break;
        }
    }
}
__device__ __forceinline__ void phase_pass2(CArgs& a, unsigned char* lds, int l) {
    for (int task = obid(); task < 528; task += gridDim.x) {
        if (task < 256) pass2_gdn(a, lds, l, task >> 3, task & 7);
        else if (task < 384) pass2_diag(a, l, 0, (task - 256) >> 2, task & 3);
        else if (task < 512) pass2_diag(a, l, 2, (task - 384) >> 2, task & 3);
        else pass2_s5(a, l, task - 512);
    }
}

template <class Epi>
__device__ __forceinline__ void run_gemm(unsigned char* lds, const bf16_t* A, const bf16_t* Bt, int M, int N, int K, const Epi& E) {
    pg8::Gemm g; g.A = A; g.Bt = Bt; g.M = M; g.N = N; g.K = K;
    pg8::StaticOrder S; S.init(M, N, gridDim.x, obid());
    pg8::gemm_phase<Epi, pg8::StaticOrder, false>((PG8_LAS unsigned char*)lds, g, S, E, nullptr);
}

constexpr int N_PHASES = 1 + 7 * DEPTH;
#ifndef MK_ONE_LAUNCH
#define MK_ONE_LAUNCH 1
#endif

__global__ void __launch_bounds__(512, 2) hybrid_fwd(Args a_in) {
    extern __shared__ __attribute__((aligned(16))) unsigned char lds_[];
    const int ph_lo = a_in.ph_lo, ph_hi = a_in.ph_hi;
#if MK_ONE_LAUNCH
    { volatile MK_LAS unsigned* st = (volatile MK_LAS unsigned*)((MK_LAS unsigned char*)lds_ + L_BARST);
      if (threadIdx.x == 0) { st[0] = 0u; st[1] = 0u; }
      __syncthreads();
      (void)xcd_barrier_post((unsigned*)(a_in.ws + WS_CTL), st); }
#endif
    for (int ph = ph_lo; ph < ph_hi; ++ph) {
        if (ph > ph_lo) {
#if MK_ONE_LAUNCH
            if (ph == ph_lo + 1) cg::this_grid().sync();
            else { XcdBarrier xb_; xb_.bar = (unsigned*)(a_in.ws + WS_CTL); xb_.x = xb_xcc_id(); xb_.st = (volatile MK_LAS unsigned*)((MK_LAS unsigned char*)lds_ + L_BARST); xcd_barrier(xb_); }
#endif
        }
        CArgs* ap = (CArgs*)__builtin_amdgcn_kernarg_segment_ptr();
        asm volatile("" : "+s"(ap));
        CArgs& a = *ap;
        unsigned char* lds = lds_;
        if (ph == 0) { phase_prologue(a, lds); continue; }
        const int l = (ph - 1) / 7, sub = (ph - 1) % 7;
#ifdef MK_DOUBLE
        for (int rep = 0; rep < (sub == MK_DOUBLE ? 2 : 1); ++rep)
#endif
        switch (sub) {
            case 0: { EpiU E; E.U = (bf16_t*)(a.ws + WS_U); E.USM = (float*)(a.ws + WS_USM);
                      run_gemm(lds, (const bf16_t*)(a.ws + WS_XB), (const bf16_t*)(a.ws + WS_WTIN) + (size_t)l * NU_PAD * 1024, MP, NU_PAD, 1024, E); } break;
#ifndef MK_NOMIX
            case 1: case 3: phase_mixer(a, lds, l, sub); break;
            case 2: phase_pass2(a, lds, l); break;
#endif
            case 4: { EpiGlu E; E.Y5 = (const bf16_t*)(a.ws + WS_Y5); E.U = (const bf16_t*)(a.ws + WS_U); E.bias = a.in[I_GLUB] + l * 256; E.MIX = (bf16_t*)(a.ws + WS_XB);
                      run_gemm(lds, (const bf16_t*)(a.ws + WS_Y5), (const bf16_t*)(a.ws + WS_WTGLU) + (size_t)l * 256 * 256, MP, 256, 256, E); } break;
            case 5: { EpiOut E; E.out = a.out; E.xmeta = (float*)(a.ws + WS_XMETA);
                      run_gemm(lds, (const bf16_t*)(a.ws + WS_XB), (const bf16_t*)(a.ws + WS_WTOUT) + (size_t)l * 1024 * 1024, MP, 1024, 1024, E); } break;
            default: phase_ln(a, l); break;
        }
    }
}
}

extern "C" void kernel_launch(void* const* d_in, const int* in_sizes, int n_in, void* d_out, int out_size, void* d_ws, size_t ws_size, hipStream_t stream) {
    using namespace mk;
    static int grid = 0;
    if (!grid) {
        int dev = 0, cus = 0, per_cu = 0;
        hipGetDevice(&dev); hipDeviceGetAttribute(&cus, hipDeviceAttributeMultiprocessorCount, dev);
        hipFuncSetAttribute((const void*)hybrid_fwd, hipFuncAttributeMaxDynamicSharedMemorySize, LDS_BYTES);
        hipOccupancyMaxActiveBlocksPerMultiprocessor(&per_cu, (const void*)hybrid_fwd, 512, LDS_BYTES);
        if (per_cu < 1) { fprintf(stderr, "kernel_launch: occupancy query says %d blocks/CU\n", per_cu); per_cu = 1; }
        grid = cus;
        if (n_in != N_IN || (size_t)out_size != O_END || ws_size < WS_CTL + CTL_BYTES) fprintf(stderr, "kernel_launch: unexpected shapes n_in %d out %d ws %zu\n", n_in, out_size, ws_size);
    }
    Args a{};
    for (int i = 0; i < N_IN; ++i) a.in[i] = (const float*)d_in[i];
    a.out = (float*)d_out; a.ws = (unsigned char*)d_ws;
#if MK_ONE_LAUNCH
    (void)hipMemsetAsync((char*)d_ws + WS_CTL, 0, CTL_BYTES, stream);
    a.ph_lo = 0; a.ph_hi = N_PHASES;
    void* args[] = {&a};
    hipError_t e = hipLaunchCooperativeKernel((const void*)hybrid_fwd, dim3(grid), dim3(512), args, LDS_BYTES, stream);
    if (e != hipSuccess) fprintf(stderr, "cooperative launch failed: %s (grid %d)\n", hipGetErrorString(e), grid);
#else
    for (int ph = 0; ph < N_PHASES; ++ph) { a.ph_lo = ph; a.ph_hi = ph + 1; hipLaunchKernelGGL(hybrid_fwd, dim3(grid), dim3(512), LDS_BYTES, stream, a); }
#endif
}
```

```cpp
#include <hip/hip_runtime.h>
#include <hip/hip_cooperative_groups.h>
#include <cstdio>
namespace cg = cooperative_groups;
namespace pg8 {
#define PG8_LAS __attribute__((address_space(3)))
typedef unsigned short bf16_t;
typedef short bf16x8 __attribute__((ext_vector_type(8)));
typedef float f32x4 __attribute__((ext_vector_type(4)));
typedef unsigned u32x4 __attribute__((ext_vector_type(4)));
constexpr int BM = 256, BK = 64, HALF = 128, HTB = HALF * BK * 2  , STAGE_BYTES = 8 * HTB, NXCD = 8, WGM = 8;

__host__ __device__ __forceinline__ int lds_byte(int r, int c) { const int st = (r >> 4) * 2 + (c >> 5), rr = r & 15, cc = c & 31, ob = rr * 64 + cc * 2; return st * 1024 + (ob ^ (((ob >> 9) & 1) << 5)); }
__host__ __device__ __forceinline__ void stage_rc(int b, int& R, int& C) { const int st = b / 1024, sb = b % 1024, swz = sb ^ (((sb >> 9) & 1) << 5); R = (st >> 1) * 16 + swz / 64; C = (st & 1) * 32 + (swz % 64) / 2; }
__host__ __device__ __forceinline__ int perm32(int rho) { const int n = rho >> 4, i = rho & 15; return 8 * (i >> 2) + 4 * n + (i & 3); }

struct Unit { int pm, pn; };
struct Gemm { const bf16_t* A; const bf16_t* Bt; int M, N, K; };

struct StaticOrder {
    int nM, nN, nwg, G, c;
    __host__ __device__ void init(int M, int N, int G_, int c_) { nM = M / BM; nN = N / BM; nwg = nM * nN; G = G_; c = c_; }
    __host__ __device__ bool next(int i, Unit& u) const {
        const int L = i * G + c; if (L >= nwg) return false;
        int wgid = L; { const int q = nwg / NXCD, r = nwg % NXCD, xcd = wgid % NXCD, off = wgid / NXCD; wgid = (xcd < r ? xcd * (q + 1) : r * (q + 1) + (xcd - r) * q) + off; }
        const int nig = WGM * nN, gid = wgid / nig, fm = gid * WGM, gsz = (nM - fm) < WGM ? (nM - fm) : WGM;
        u.pm = fm + ((wgid % nig) % gsz); u.pn = (wgid % nig) / gsz; return true;
    }
    __device__ __forceinline__ void a_ready(const Unit&) const {}
    __device__ __forceinline__ void done(const Unit&) const {}
};
__device__ __forceinline__ unsigned cvt_pk_bf16(float lo, float hi) { unsigned r; asm volatile("v_cvt_pk_bf16_f32 %0, %1, %2" : "=v"(r) : "v"(lo), "v"(hi)); return r; }
typedef float f32x2 __attribute__((ext_vector_type(2)));
template <class Epi, class Sched, bool STAMP = false>
__device__ __forceinline__ void gemm_phase(PG8_LAS unsigned char* lds, const Gemm g, const Sched& S, const Epi& E, unsigned long long* stamps) {
    int tid_ = threadIdx.x; asm volatile("" : "+v"(tid_)); const int tid = tid_, wid = __builtin_amdgcn_readfirstlane(tid >> 6), lane = tid & 63, wr = wid >> 2, wc = wid & 3, fr = lane & 15, fq = lane >> 4;
    const int K = g.K, nt = K / BK;
    int ts_lo = 0, ts_hi = 0, nts = 0; const unsigned long long rt_entry = STAMP ? (unsigned long long)wall_clock64() : 0ull;
#define PG8_STAMP() do { if (STAMP && wid == 0 && nts < 64) { const unsigned long long _c = (unsigned long long)clock64(); \
        ts_lo = (lane == nts) ? (int)(unsigned)_c : ts_lo; ts_hi = (lane == nts) ? (int)(unsigned)(_c >> 32) : ts_hi; ++nts; } } while (0)
    PG8_STAMP();
    unsigned voffA[2], voffB[2];
#pragma unroll
    for (int i = 0; i < 2; ++i) { int R, C; stage_rc(tid * 16 + i * 8192, R, C); const int Rb = Epi::PERM ? ((R & ~31) + perm32(R & 31)) : R;
        voffA[i] = (unsigned)(R * K + C) * 2u; voffB[i] = (unsigned)(Rb * K + C) * 2u; }
    const size_t kstep = (size_t)(BK * 2);
    const size_t hstep = (size_t)HALF * K * 2;
    const size_t tstep = 2 * hstep;
    const unsigned ldsw = (unsigned)wid * 1024u;
    const int aoff = lds_byte(wr * 64 + fr, fq * 8), boff = lds_byte(wc * 32 + fr, fq * 8);
#define PG8_SA(b, h) (((b) * 2 + (h)) * HTB)
#define PG8_SB(b, h) ((4 + (b) * 2 + (h)) * HTB)
#define PG8_STAGE(bufoff, gbase, voff) do { _Pragma("unroll") for (int _i = 0; _i < 2; ++_i) \
        __builtin_amdgcn_global_load_lds((const unsigned*)((const char*)(gbase) + (voff)[_i]), (PG8_LAS unsigned*)(lds + (bufoff) + ldsw + _i * 8192), 16, 0, 0); } while (0)
#define PG8_LDA(dst, b, h) do { _Pragma("unroll") for (int m = 0; m < 4; ++m) _Pragma("unroll") for (int k = 0; k < 2; ++k) dst[m][k] = *(const PG8_LAS bf16x8*)(lds + PG8_SA(b, h) + aoff + m * 2048 + k * 1024); } while (0)
#define PG8_LDB(dst, b, h) do { _Pragma("unroll") for (int n = 0; n < 2; ++n) _Pragma("unroll") for (int k = 0; k < 2; ++k) dst[n][k] = *(const PG8_LAS bf16x8*)(lds + PG8_SB(b, h) + boff + n * 2048 + k * 1024); } while (0)
#define PG8_MMA(ai, bj, At, Bt) do { __builtin_amdgcn_s_setprio(1); _Pragma("unroll") for (int m = 0; m < 4; ++m) _Pragma("unroll") for (int n = 0; n < 2; ++n) _Pragma("unroll") for (int k = 0; k < 2; ++k) \
        acc[ai][bj][m][n] = __builtin_amdgcn_mfma_f32_16x16x32_bf16(Bt[n][k], At[m][k], acc[ai][bj][m][n], 0, 0, 0); __builtin_amdgcn_s_setprio(0); } while (0)
#define PG8_WAIT_V(n) asm volatile("s_waitcnt vmcnt(" #n ")" ::: "memory")
#define PG8_WAIT_L(n) asm volatile("s_waitcnt lgkmcnt(" #n ")" ::: "memory")
#define PG8_BAR __builtin_amdgcn_s_barrier()
#define PG8_SCHED __builtin_amdgcn_sched_barrier(0)
    Unit cur, nxt; int ui = 0;
    if (!S.next(0, cur)) return;
    f32x4 acc[2][2][4][2];
#pragma unroll
    for (int a = 0; a < 2; ++a)
#pragma unroll
        for (int b = 0; b < 2; ++b)
#pragma unroll
            for (int m = 0; m < 4; ++m)
#pragma unroll
                for (int n = 0; n < 2; ++n) acc[a][b][m][n] = (f32x4){0.f, 0.f, 0.f, 0.f};
    bf16x8 At[4][2], B0[2][2], B1[2][2];
    const char* cA = (const char*)g.A + (size_t)cur.pm * tstep; const char* cB = (const char*)g.Bt + (size_t)cur.pn * tstep;
    S.a_ready(cur);
    PG8_STAGE(PG8_SB(0, 0), cB, voffB); PG8_STAGE(PG8_SA(0, 0), cA, voffA); PG8_STAGE(PG8_SB(0, 1), cB + hstep, voffB); PG8_STAGE(PG8_SA(0, 1), cA + hstep, voffA);
    if (wr == 1) PG8_BAR;
    PG8_WAIT_V(4); PG8_BAR;
    PG8_STAGE(PG8_SB(1, 0), cB + kstep, voffB); PG8_STAGE(PG8_SA(1, 0), cA + kstep, voffA); PG8_STAGE(PG8_SB(1, 1), cB + hstep + kstep, voffB);
    PG8_WAIT_V(6); PG8_BAR;
    PG8_STAMP();
    for (;;) {
        const bool has_next = S.next(ui + 1, nxt);
        const char* nA = has_next ? (const char*)g.A + (size_t)nxt.pm * tstep : cA; const char* nB = has_next ? (const char*)g.Bt + (size_t)nxt.pn * tstep : cB;
        for (int t = 0; t < nt; t += 2) {
            const bool last = (t == nt - 2);
            const char* a1 = cA + (size_t)(t + 1) * kstep;
            const char* a2 = last ? nA : cA + (size_t)(t + 2) * kstep; const char* b2 = last ? nB : cB + (size_t)(t + 2) * kstep;
            const char* a3 = a2 + kstep; const char* b3 = b2 + kstep;
            if (last && has_next) S.a_ready(nxt);
            PG8_LDB(B0, 0, 0); PG8_SCHED; PG8_LDA(At, 0, 0); PG8_STAGE(PG8_SA(1, 1), a1 + hstep, voffA);
            PG8_WAIT_L(8); PG8_BAR; PG8_WAIT_L(0); PG8_MMA(0, 0, At, B0); PG8_BAR; PG8_SCHED;
            PG8_LDB(B1, 0, 1); PG8_STAGE(PG8_SB(0, 0), b2, voffB);
            PG8_BAR; PG8_WAIT_L(0); PG8_MMA(0, 1, At, B1); PG8_BAR;
            PG8_LDA(At, 0, 1); PG8_STAGE(PG8_SA(0, 0), a2, voffA);
            PG8_BAR; PG8_WAIT_L(0); PG8_MMA(1, 0, At, B0); PG8_BAR; PG8_SCHED;
            PG8_STAGE(PG8_SB(0, 1), b2 + hstep, voffB);
            PG8_WAIT_V(6); PG8_BAR; PG8_MMA(1, 1, At, B1); PG8_BAR;
            PG8_LDB(B0, 1, 0); PG8_SCHED; PG8_LDA(At, 1, 0); PG8_STAGE(PG8_SA(0, 1), a2 + hstep, voffA);
            PG8_WAIT_L(8); PG8_BAR; PG8_WAIT_L(0); PG8_MMA(0, 0, At, B0); PG8_BAR; PG8_SCHED;
            PG8_LDB(B1, 1, 1); PG8_STAGE(PG8_SB(1, 0), b3, voffB);
            PG8_BAR; PG8_WAIT_L(0); PG8_MMA(0, 1, At, B1); PG8_BAR;
            PG8_LDA(At, 1, 1); PG8_STAGE(PG8_SA(1, 0), a3, voffA);
            PG8_BAR; PG8_WAIT_L(0); PG8_MMA(1, 0, At, B0); PG8_BAR; PG8_SCHED;
            PG8_STAGE(PG8_SB(1, 1), b3 + hstep, voffB);
            PG8_WAIT_V(6); PG8_BAR; PG8_MMA(1, 1, At, B1); PG8_BAR;
        }
        PG8_STAMP();
        if constexpr (!Epi::AFTER_DRAIN) { E(acc, cur, wr, wc, fr, fq); S.done(cur); }
        PG8_STAMP();
        if (!has_next) break;
#pragma unroll
        for (int a = 0; a < 2; ++a)
#pragma unroll
            for (int b = 0; b < 2; ++b)
#pragma unroll
                for (int m = 0; m < 4; ++m)
#pragma unroll
                    for (int n = 0; n < 2; ++n) acc[a][b][m][n] = (f32x4){0.f, 0.f, 0.f, 0.f};
        cur = nxt; cA = nA; cB = nB; ++ui;
    }
    PG8_WAIT_V(0);
    if (wr == 0) PG8_BAR;
    PG8_BAR;
    if constexpr (Epi::AFTER_DRAIN) { E.fused(acc, cur, wr, wc, fr, fq, lds, wid, lane); S.done(cur); }
    PG8_STAMP();
    if (STAMP && wid == 0) { stamps[lane] = lane < nts ? (((unsigned long long)(unsigned)ts_hi << 32) | (unsigned)ts_lo) : 0ull;
        if (lane == 62) stamps[62] = rt_entry; if (lane == 63) stamps[63] = (unsigned long long)wall_clock64(); }
#undef PG8_STAMP
#undef PG8_SA
#undef PG8_SB
#undef PG8_STAGE
#undef PG8_LDA
#undef PG8_LDB
#undef PG8_MMA
#undef PG8_WAIT_V
#undef PG8_WAIT_L
#undef PG8_BAR
#undef PG8_SCHED
}
}

namespace mk {
using pg8::bf16_t; using pg8::f32x4; using pg8::u32x4; using pg8::Unit; using pg8::cvt_pk_bf16;
typedef unsigned u32x2 __attribute__((ext_vector_type(2)));
using pg8::f32x2;
#define MK_LAS __attribute__((address_space(3)))
typedef MK_LAS float lfloat;
typedef MK_LAS f32x4 lf32x4;

constexpr int D = 1024, DEPTH = 4, TP = 2064, BP = 8, BS = 128, TS = 4;
constexpr int M_REAL = 17024, MP = 17152, ROW_SAMPLE = 16384, ROW_META = 16896;
constexpr int D_IN = 3340, NU = 3328, NU_PAD = 3584;
constexpr int CL = 129, NCH = 16, ST = 43;
constexpr int UC_ZA = 0, UC_XBC = 256, UC_ZB = 768, UC_UB = 1024, UC_ZC = 1280, UC_QKV = 1536, UC_ZD = 2304, UC_QD = 2560, UC_FD = 2816, UC_ID = 3072;
constexpr float DN_ALPHA = 1.6817928305074290f;
constexpr float LN_EPS = 1e-5f, RMS_EPS = 1e-6f, L2_EPS = 1e-6f;

enum { I_XP = 0, I_XS, I_SSSD, I_SSSDC, I_SS5R, I_SS5I, I_SGDN, I_SGDNC, I_SHG, I_META, I_LNIG, I_LNIB, I_WIN, I_SCW, I_SCB, I_SDTB, I_SALOG, I_SD, I_SNG,
       I_LAMR, I_LAMI, I_LOGDT, I_BR, I_BI, I_CR, I_CI, I_S5D, I_GLUW, I_GLUB, I_GCW, I_GCB, I_GALOG, I_GDTB, I_GNG, I_HLB, I_HNG, I_WOUT, I_LNG, I_LNB, N_IN };

constexpr size_t O_YP = 0, O_YS = O_YP + (size_t)8 * 2048 * 1024, O_PSSD = O_YS + (size_t)128 * 4 * 1024;
constexpr size_t SZ_ST = 4 * 64 * 64, SZ_SC = 3 * 512, SZ_S5 = 16 * 64, SZ_GC = 3 * 768;
constexpr size_t O_PSSDC = O_PSSD + 4 * 8 * SZ_ST, O_PS5R = O_PSSDC + 4 * 8 * SZ_SC, O_PS5I = O_PS5R + 4 * 8 * SZ_S5, O_PGDN = O_PS5I + 4 * 8 * SZ_S5,
                 O_PGDNC = O_PGDN + 4 * 8 * SZ_ST, O_PHG = O_PGDNC + 4 * 8 * SZ_GC, O_SSSD = O_PHG + 4 * 8 * SZ_ST, O_SSSDC = O_SSSD + 4 * 128 * SZ_ST,
                 O_SS5R = O_SSSDC + 4 * 128 * SZ_SC, O_SS5I = O_SS5R + 4 * 128 * SZ_S5, O_SGDN = O_SS5I + 4 * 128 * SZ_S5, O_SGDNC = O_SGDN + 4 * 128 * SZ_ST,
                 O_SHG = O_SGDNC + 4 * 128 * SZ_GC, O_END = O_SHG + 4 * 128 * SZ_ST;
static_assert(O_END == 47243264, "d_out size");

constexpr size_t WS_WTIN = 0;
constexpr size_t WS_WTOUT = WS_WTIN + (size_t)4 * NU_PAD * 1024 * 2;
constexpr size_t WS_WTGLU = WS_WTOUT + (size_t)4 * 1024 * 1024 * 2;
constexpr size_t WS_XB = WS_WTGLU + (size_t)4 * 256 * 256 * 2;
constexpr size_t WS_XMETA = WS_XB + (size_t)MP * 1024 * 2;
constexpr size_t WS_U = WS_XMETA + (size_t)128 * 1024 * 4;
constexpr size_t WS_USM = WS_U + (size_t)MP * NU * 2;
constexpr size_t WS_Y5 = WS_USM + (size_t)MP * 16 * 4;
constexpr size_t WS_SG = WS_Y5 + (size_t)MP * 256 * 2;
constexpr size_t WS_PG = WS_SG + (size_t)32 * 16 * 4096 * 4;
constexpr size_t WS_SS = WS_PG + (size_t)32 * 16 * 4096 * 4;
constexpr size_t WS_SH = WS_SS + (size_t)32 * 16 * 4096 * 4;
constexpr size_t WS_DS = WS_SH + (size_t)32 * 16 * 4096 * 4;
constexpr size_t WS_DH = WS_DS + 4096;
constexpr size_t WS_H5 = WS_DH + (size_t)32 * 16 * 64 * 4;
constexpr size_t WS_END = WS_H5 + (size_t)8 * 16 * 16 * 128 * 4;
constexpr size_t WS_CTL = WS_END;
constexpr size_t CTL_BYTES = 16384;
static_assert(WS_CTL + CTL_BYTES <= 268435456, "ws");
constexpr int L_BARST = 147456 - 16;

constexpr int LDS_BYTES = 147456;
constexpr int H_RAW = 0, H_ACT = 17664, H_ZB = 61696, H_SCAL = 67200, H_MISC = 67712, H_CWL = 67968, H_STRIDE = 71808, H_OBUF = H_RAW;
static_assert(H_ACT == (ST + 3) * 192 * 2 && H_ZB == H_ACT + ST * 256 * 4 && H_SCAL == H_ZB + ST * 64 * 2 && ST * 64 * 4 <= H_ACT && (2 * ST + 1) * 4 <= 512, "lds map");
static_assert(2 * 16640 <= H_ZB && 2 * H_STRIDE <= 147456 - 16, "lds");

struct Args { const float* in[N_IN]; float* out; unsigned char* ws; int ph_lo, ph_hi; };
typedef __attribute__((address_space(4))) const Args CArgs;

__device__ __forceinline__ int otid() { int t = threadIdx.x; asm volatile("" : "+v"(t)); return t; }
#define MK_OPQ(p) asm volatile("" : "+s"(p))
__device__ __forceinline__ int obid() { int t = blockIdx.x; asm volatile("" : "+s"(t)); return t; }
__device__ __forceinline__ float bf2f(bf16_t v) { return __uint_as_float(((unsigned)v) << 16); }
__device__ __forceinline__ bf16_t f2bf(float f) { unsigned u = __float_as_uint(f); return (bf16_t)((u + 0x7fffu + ((u >> 16) & 1u)) >> 16); }
__device__ __forceinline__ unsigned pk2(float lo, float hi) { return (unsigned)f2bf(lo) | ((unsigned)f2bf(hi) << 16); }
__device__ __forceinline__ float sigm(float x) { return __builtin_amdgcn_rcpf(1.f + __expf(-x)); }
__device__ __forceinline__ float silu(float x) { return x * __builtin_amdgcn_rcpf(1.f + __expf(-x)); }
__device__ __forceinline__ float softplus(float x) { const float e = __expf(x); return x > 15.f ? x : (e < 0.01f ? e * (1.f - e * (0.5f - e * 0.33333333f)) : __logf(1.f + e)); }
__device__ __forceinline__ float gelu_tanh(float x) { const float u = 0.7978845608028654f * (x + 0.044715f * x * x * x); const float t = __expf(2.f * u); return 0.5f * x * (2.f - 2.f * __builtin_amdgcn_rcpf(1.f + t)); }
__device__ __forceinline__ float wave_sum(float v, int lane) {
#pragma unroll
    for (int o = 1; o < 64; o <<= 1) v += __builtin_bit_cast(float, __builtin_amdgcn_ds_bpermute((lane ^ o) << 2, __builtin_bit_cast(int, v)));
    return v;
}
__device__ __forceinline__ float red8(float x) {
    x += __builtin_bit_cast(float, __builtin_amdgcn_update_dpp(0, __builtin_bit_cast(int, x), 0xB1, 0xF, 0xF, true));
    x += __builtin_bit_cast(float, __builtin_amdgcn_update_dpp(0, __builtin_bit_cast(int, x), 0x4E, 0xF, 0xF, true));
    x += __builtin_bit_cast(float, __builtin_amdgcn_update_dpp(0, __builtin_bit_cast(int, x), 0x141, 0xF, 0xF, true));
    return x;
}
__device__ __forceinline__ void lds_barrier() { asm volatile("s_waitcnt lgkmcnt(0)" ::: "memory"); __builtin_amdgcn_s_barrier(); asm volatile("" ::: "memory"); }
__device__ __forceinline__ int prow(int b, int t) { return t < 16 ? ROW_META + b * 16 + t : b * 2048 + t - 16; }
__device__ __forceinline__ float* xrow_ptr(CArgs& a, int row) { return row < ROW_META ? a.out + (size_t)row * D : (float*)(a.ws + WS_XMETA) + (size_t)(row - ROW_META) * D; }

__device__ __forceinline__ void transpose_item(const float* W, int ldw, int K, int k0, int ns0, bf16_t* WT, int nd0, lfloat* scr, int lane) {
#pragma unroll 8
    for (int i = 0; i < 32; ++i) { const int kk = 2 * i + (lane >> 5); scr[kk * 33 + (lane & 31)] = W[(size_t)(k0 + kk) * ldw + ns0 + (lane & 31)]; }
    __builtin_amdgcn_wave_barrier(); asm volatile("s_waitcnt lgkmcnt(0)" ::: "memory");
    const int c = lane & 7;
#pragma unroll
    for (int j = 0; j < 4; ++j) { const int n = (lane >> 3) + 8 * j; const lfloat* s = scr + (8 * c) * 33 + n;
        u32x4 o; o.x = pk2(s[0 * 33], s[1 * 33]); o.y = pk2(s[2 * 33], s[3 * 33]); o.z = pk2(s[4 * 33], s[5 * 33]); o.w = pk2(s[6 * 33], s[7 * 33]);
        *(u32x4*)(WT + (size_t)(nd0 + n) * K + k0 + 8 * c) = o; }
    __builtin_amdgcn_wave_barrier(); asm volatile("s_waitcnt lgkmcnt(0)" ::: "memory");
}
__device__ __forceinline__ void ln_row(const float* src, const float* g, const float* bb, float* dstf, bf16_t* dstb, int lane) {
    const f32x4* xr = (const f32x4*)src + lane;
    f32x4 v[4]; float s = 0.f;
#pragma unroll
    for (int j = 0; j < 4; ++j) { v[j] = xr[64 * j]; s += (v[j].x + v[j].y) + (v[j].z + v[j].w); }
    const float mean = wave_sum(s, lane) * (1.f / D); float s2 = 0.f;
#pragma unroll
    for (int j = 0; j < 4; ++j) { v[j] = v[j] - mean; s2 += (v[j].x * v[j].x + v[j].y * v[j].y) + (v[j].z * v[j].z + v[j].w * v[j].w); }
    const float rstd = __builtin_amdgcn_rsqf(wave_sum(s2, lane) * (1.f / D) + LN_EPS);
#pragma unroll
    for (int j = 0; j < 4; ++j) {
        const f32x4 gv = ((const f32x4*)g)[lane + 64 * j], bv = ((const f32x4*)bb)[lane + 64 * j];
        const f32x4 o = v[j] * rstd * gv + bv;
        ((f32x4*)dstf)[lane + 64 * j] = o;
        u32x2 w; w.x = pk2(o.x, o.y); w.y = pk2(o.z, o.w);
        ((u32x2*)dstb)[lane + 64 * j] = w;
    }
}

__device__ __forceinline__ void phase_prologue(CArgs& a, unsigned char* ldsg) {
    const int tid = otid(), lane = tid & 63, wave = tid >> 6;
    lfloat* scr = (lfloat*)(MK_LAS unsigned char*)ldsg + wave * 4096;
    const int gw = obid() * 8 + wave, NGW = gridDim.x * 8;
    constexpr int I_IN = 16 * (NU / 32), I_OUT = 16 * 32, I_GLU = 4 * 8;
    constexpr int NITEMS = 4 * (I_IN + I_OUT + I_GLU);
    bf16_t* wtin = (bf16_t*)(a.ws + WS_WTIN); bf16_t* wtout = (bf16_t*)(a.ws + WS_WTOUT); bf16_t* wtglu = (bf16_t*)(a.ws + WS_WTGLU);
    for (int it = gw; it < NITEMS; it += NGW) {
        int r = it;
        if (r < 4 * I_IN) { const int l = r / I_IN; r -= l * I_IN; const int kb = r / (NU / 32), nb = r % (NU / 32); const int nd0 = nb * 32; const int ns0 = nd0 + (nd0 >= 768 ? 4 : 0) + (nd0 >= 2304 ? 8 : 0);
            transpose_item(a.in[I_WIN] + (size_t)l * 1024 * D_IN, D_IN, 1024, kb * 64, ns0, wtin + (size_t)l * NU_PAD * 1024, nd0, scr, lane); continue; }
        r -= 4 * I_IN;
        if (r < 4 * I_OUT) { const int l = r / I_OUT; r -= l * I_OUT; const int kb = r / 32, nb = r % 32;
            transpose_item(a.in[I_WOUT] + (size_t)l * 1024 * 1024, 1024, 1024, kb * 64, nb * 32, wtout + (size_t)l * 1024 * 1024, nb * 32, scr, lane); continue; }
        r -= 4 * I_OUT;
        { const int l = r / I_GLU; r -= l * I_GLU; const int kb = r / 8, nb = r % 8;
            transpose_item(a.in[I_GLUW] + (size_t)l * 256 * 256, 256, 256, kb * 64, nb * 32, wtglu + (size_t)l * 256 * 256, nb * 32, scr, lane); }
    }
    for (int idx = obid() * 512 + tid; idx < 4 * 12 * 1024; idx += gridDim.x * 512) {
        const int l = idx / (12 * 1024), r = idx % (12 * 1024), j = r >> 10, k = r & 1023; const int sc = j < 4 ? 768 + j : 2308 + (j - 4);
        wtin[((size_t)l * NU_PAD + NU + j) * 1024 + k] = f2bf(a.in[I_WIN][((size_t)l * 1024 + k) * D_IN + sc]);
    }
    bf16_t* xb = (bf16_t*)(a.ws + WS_XB);
    for (int row = gw; row < M_REAL; row += NGW) {
        const float* src = row < ROW_SAMPLE ? a.in[I_XP] + (size_t)row * D : (row < ROW_META ? a.in[I_XS] + (size_t)(row - ROW_SAMPLE) * D : a.in[I_META] + (size_t)((row - ROW_META) & 15) * D);
        ln_row(src, a.in[I_LNIG], a.in[I_LNIB], xrow_ptr(a, row), xb + (size_t)row * D, lane);
    }
}
__device__ __forceinline__ void ln_row2(const float* src0, const float* src1, const float* g, const float* bb, float* d0, float* d1, bf16_t* b0, bf16_t* b1, int lane, const bool write_b = true) {
    const f32x4* x0 = (const f32x4*)src0 + lane; const f32x4* x1 = (const f32x4*)src1 + lane;
    f32x4 v0[4], v1[4]; float s0 = 0.f, s1 = 0.f;
#pragma unroll
    for (int j = 0; j < 4; ++j) { v0[j] = x0[64 * j]; v1[j] = x1[64 * j]; }
#pragma unroll
    for (int j = 0; j < 4; ++j) { s0 += (v0[j].x + v0[j].y) + (v0[j].z + v0[j].w); s1 += (v1[j].x + v1[j].y) + (v1[j].z + v1[j].w); }
#pragma unroll
    for (int o = 1; o < 64; o <<= 1) { s0 += __builtin_bit_cast(float, __builtin_amdgcn_ds_bpermute((lane ^ o) << 2, __builtin_bit_cast(int, s0))); s1 += __builtin_bit_cast(float, __builtin_amdgcn_ds_bpermute((lane ^ o) << 2, __builtin_bit_cast(int, s1))); }
    const float m0 = s0 * (1.f / D), m1 = s1 * (1.f / D); float q0 = 0.f, q1 = 0.f;
#pragma unroll
    for (int j = 0; j < 4; ++j) { v0[j] = v0[j] - m0; v1[j] = v1[j] - m1; q0 += (v0[j].x * v0[j].x + v0[j].y * v0[j].y) + (v0[j].z * v0[j].z + v0[j].w * v0[j].w); q1 += (v1[j].x * v1[j].x + v1[j].y * v1[j].y) + (v1[j].z * v1[j].z + v1[j].w * v1[j].w); }
#pragma unroll
    for (int o = 1; o < 64; o <<= 1) { q0 += __builtin_bit_cast(float, __builtin_amdgcn_ds_bpermute((lane ^ o) << 2, __builtin_bit_cast(int, q0))); q1 += __builtin_bit_cast(float, __builtin_amdgcn_ds_bpermute((lane ^ o) << 2, __builtin_bit_cast(int, q1))); }
    const float r0 = __builtin_amdgcn_rsqf(q0 * (1.f / D) + LN_EPS), r1 = __builtin_amdgcn_rsqf(q1 * (1.f / D) + LN_EPS);
#pragma unroll
    for (int j = 0; j < 4; ++j) {
        const f32x4 gv = ((const f32x4*)g)[lane + 64 * j], bv = ((const f32x4*)bb)[lane + 64 * j];
        const f32x4 o0 = v0[j] * r0 * gv + bv, o1 = v1[j] * r1 * gv + bv;
        ((f32x4*)d0)[lane + 64 * j] = o0; ((f32x4*)d1)[lane + 64 * j] = o1;
        u32x2 w0, w1; w0.x = pk2(o0.x, o0.y); w0.y = pk2(o0.z, o0.w); w1.x = pk2(o1.x, o1.y); w1.y = pk2(o1.z, o1.w);
        if (write_b) { ((u32x2*)b0)[lane + 64 * j] = w0; ((u32x2*)b1)[lane + 64 * j] = w1; }
    }
}
__device__ __forceinline__ void phase_ln(CArgs& a, int l) {
    const int lane = otid() & 63, wave = otid() >> 6, bid = obid();
    bf16_t* xb = (bf16_t*)(a.ws + WS_XB);
    const float* g = a.in[I_LNG] + l * D; const float* bb = a.in[I_LNB] + l * D;
    if (gridDim.x == 256) {
        const int x = bid & 7, wx = (bid >> 3) * 8 + wave;
        for (int p = wx; p < 1024; p += 256) { const int row = 2048 * x + 2 * p; float* x0 = xrow_ptr(a, row); float* x1 = xrow_ptr(a, row + 1);
            ln_row2(x0, x1, g, bb, x0, x1, xb + (size_t)row * D, xb + (size_t)(row + 1) * D, lane, l != DEPTH - 1); }
        const int gw = bid * 8 + wave;
        if (gw < (M_REAL - 16384) / 2) { const int row = 16384 + 2 * gw; float* x0 = xrow_ptr(a, row); float* x1 = xrow_ptr(a, row + 1);
            ln_row2(x0, x1, g, bb, x0, x1, xb + (size_t)row * D, xb + (size_t)(row + 1) * D, lane, l != DEPTH - 1); }
    } else {
        const int gw = bid * 8 + wave, NGW = gridDim.x * 8;
        for (int row = gw * 2; row < M_REAL; row += NGW * 2) { float* x0 = xrow_ptr(a, row); float* x1 = xrow_ptr(a, row + 1);
            ln_row2(x0, x1, g, bb, x0, x1, xb + (size_t)row * D, xb + (size_t)(row + 1) * D, lane, l != DEPTH - 1); }
    }
}

struct EpiU {
    static constexpr bool PERM = true, AFTER_DRAIN = false;
    bf16_t* U; float* USM;
    __device__ __forceinline__ void operator()(const f32x4 (&acc)[2][2][4][2], const Unit& u, int wr_, int wc_, int fr_, int fq_) const {
        const int tid = otid(), lane = tid & 63, wid = __builtin_amdgcn_readfirstlane(tid >> 6), wr = wid >> 2, wc = wid & 3, fr = lane & 15, fq = lane >> 4;
        const int row0 = u.pm * 256 + wr * 64 + fr;
        if (u.pn < 13) {
            const int col0 = u.pn * 256 + wc * 32 + 8 * fq;
#pragma unroll
            for (int ai = 0; ai < 2; ++ai)
#pragma unroll
                for (int m = 0; m < 4; ++m) { bf16_t* rowp = U + (size_t)(row0 + ai * 128 + m * 16) * NU + col0;
#pragma unroll
                    for (int bj = 0; bj < 2; ++bj) { const f32x4 v0 = acc[ai][bj][m][0], v1 = acc[ai][bj][m][1];
                        u32x4 w; w.x = cvt_pk_bf16(v0[0], v0[1]); w.y = cvt_pk_bf16(v0[2], v0[3]); w.z = cvt_pk_bf16(v1[0], v1[1]); w.w = cvt_pk_bf16(v1[2], v1[3]);
                        *(u32x4*)(rowp + bj * 128) = w; }
                    asm volatile("" ::: "memory"); }
        } else if (wc == 0 && fq < 2) {
#pragma unroll
            for (int ai = 0; ai < 2; ++ai)
#pragma unroll
                for (int m = 0; m < 4; ++m) { float* rowp = USM + (size_t)(row0 + ai * 128 + m * 16) * 16 + 8 * fq;
                    *(f32x4*)(rowp) = acc[ai][0][m][0]; *(f32x4*)(rowp + 4) = acc[ai][0][m][1]; }
        }
    }
};
struct EpiGlu {
    static constexpr bool PERM = true, AFTER_DRAIN = false;
    const bf16_t* Y5; const bf16_t* U; const float* bias; bf16_t* MIX;
    __device__ __forceinline__ void operator()(const f32x4 (&acc)[2][2][4][2], const Unit& u, int wr_, int wc_, int fr_, int fq_) const {
        const int tid = otid(), lane = tid & 63, wid = __builtin_amdgcn_readfirstlane(tid >> 6), wr = wid >> 2, wc = wid & 3, fr = lane & 15, fq = lane >> 4;
        const int row0 = u.pm * 256 + wr * 64 + fr, col0 = wc * 32 + 8 * fq;
#pragma unroll
        for (int ai = 0; ai < 2; ++ai)
#pragma unroll
            for (int m = 0; m < 4; ++m) { const size_t row = (size_t)(row0 + ai * 128 + m * 16);
                u32x4 yv[2], zv[2];
#pragma unroll
                for (int bj = 0; bj < 2; ++bj) { const int col = col0 + bj * 128; yv[bj] = *(const u32x4*)(Y5 + row * 256 + col); zv[bj] = *(const u32x4*)(U + row * NU + UC_ZB + col); }
#pragma unroll
                for (int bj = 0; bj < 2; ++bj) { const int col = col0 + bj * 128;
                    const f32x4 b0 = *(const f32x4*)(bias + col), b1 = *(const f32x4*)(bias + col + 4);
                    float o[8];
#pragma unroll
                    for (int j = 0; j < 8; ++j) { const float g = (j < 4 ? acc[ai][bj][m][0][j & 3] : acc[ai][bj][m][1][j & 3]) + (j < 4 ? b0[j & 3] : b1[j & 3]);
                        const unsigned yw = yv[bj][j >> 1], zw = zv[bj][j >> 1];
                        const float y = __uint_as_float((j & 1) ? (yw & 0xffff0000u) : (yw << 16)), z = __uint_as_float((j & 1) ? (zw & 0xffff0000u) : (zw << 16));
                        o[j] = y * sigm(g) * silu(z); }
                    u32x4 w; w.x = pk2(o[0], o[1]); w.y = pk2(o[2], o[3]); w.z = pk2(o[4], o[5]); w.w = pk2(o[6], o[7]);
                    *(u32x4*)(MIX + row * 1024 + 256 + col) = w; }
                asm volatile("" ::: "memory"); }
    }
};
struct EpiOut {
    static constexpr bool PERM = false, AFTER_DRAIN = false;
    float* out; float* xmeta;
    __device__ __forceinline__ void operator()(const f32x4 (&acc)[2][2][4][2], const Unit& u, int wr_, int wc_, int fr_, int fq_) const {
        const int tid = otid(), lane = tid & 63, wid = __builtin_amdgcn_readfirstlane(tid >> 6), wr = wid >> 2, wc = wid & 3, fr = lane & 15, fq = lane >> 4;
        const int row0 = u.pm * 256 + wr * 64 + fr, col0 = u.pn * 256 + wc * 32 + 4 * fq;
#pragma unroll
        for (int ai = 0; ai < 2; ++ai) { const int mb = 0;
            f32x4 xv[4][2][2];
#pragma unroll
            for (int m = mb; m < mb + 4; ++m) { const int row = row0 + ai * 128 + m * 16;
                if (row < M_REAL) { const float* rowp = (row < ROW_META ? out + (size_t)row * D : xmeta + (size_t)(row - ROW_META) * D) + col0;
#pragma unroll
                    for (int bj = 0; bj < 2; ++bj)
#pragma unroll
                        for (int n = 0; n < 2; ++n) xv[m][bj][n] = *(const f32x4*)(rowp + bj * 128 + n * 16); } }
#pragma unroll
            for (int m = mb; m < mb + 4; ++m) { const int row = row0 + ai * 128 + m * 16;
                if (row < M_REAL) { float* rowp = (row < ROW_META ? out + (size_t)row * D : xmeta + (size_t)(row - ROW_META) * D) + col0;
#pragma unroll
                    for (int bj = 0; bj < 2; ++bj)
#pragma unroll
                        for (int n = 0; n < 2; ++n) *(f32x4*)(rowp + bj * 128 + n * 16) = xv[m][bj][n] * DN_ALPHA + acc[ai][bj][m][n]; } }
            asm volatile("" ::: "memory");
        }
    }
};

typedef MK_LAS f32x2 lf32x2;
template <int BR, int MODE>
__device__ __forceinline__ void rec_task(CArgs& a, unsigned char* ldsg, const int l, const bool sample, const int b, const int hp, const int c) {
    const int tid = otid(), hf = __builtin_amdgcn_readfirstlane(tid >> 8), tl = tid & 255, vp = tl >> 3, kq = tl & 7, h = hp * 2 + hf;
    MK_LAS unsigned char* lds = (MK_LAS unsigned char*)ldsg + hf * H_STRIDE;
    MK_LAS bf16_t* RAW = (MK_LAS bf16_t*)(lds + H_RAW); lfloat* ACT = (lfloat*)(lds + H_ACT); lfloat* OBUF = (lfloat*)(lds + H_OBUF); lfloat* SCAL = (lfloat*)(lds + H_SCAL);
    lfloat* MISC = (lfloat*)(lds + H_MISC); lfloat* CWL = (lfloat*)(lds + H_CWL); lfloat* SBUF = (lfloat*)(lds + H_RAW); lfloat* SBUF2 = SBUF + 4160; MK_LAS bf16_t* ZB = (MK_LAS bf16_t*)(lds + H_ZB);
    const bf16_t* U = (const bf16_t*)(a.ws + WS_U); const float* USM = (const float*)(a.ws + WS_USM); bf16_t* MIX = (bf16_t*)(a.ws + WS_XB);
    MK_OPQ(U); MK_OPQ(USM); MK_OPQ(MIX);
    const int nsteps = sample ? TS : CL, t0 = sample ? 0 : c * CL, bh = b * 4 + h, grp = h >> 1;
    const int NC = BR == 0 ? 512 : 768;
    const float* cw = BR == 0 ? a.in[I_SCW] + l * 4 * 512 : a.in[I_GCW] + l * 4 * 768;
    const float* cbias = BR == 0 ? a.in[I_SCB] + l * 512 : a.in[I_GCB] + l * 768;
    const float* cstate = BR == 0 ? a.in[I_SSSDC] + (size_t)(l * 128 + b) * 3 * 512 : a.in[I_SGDNC] + (size_t)(l * 128 + b) * 3 * 768;
    const int uc0 = BR == 0 ? UC_XBC + h * 64 : UC_QKV + h * 64, uc1 = BR == 0 ? UC_XBC + 256 + grp * 64 : UC_QKV + 256 + h * 64, uc2 = BR == 0 ? UC_XBC + 384 + grp * 64 : UC_QKV + 512 + h * 64;
    const int zcol = (BR == 0 ? UC_ZA : (BR == 1 ? UC_ZC : UC_ZD)) + h * 64, mixcol = (BR == 0 ? 0 : (BR == 1 ? 512 : 768)) + h * 64;
    const float* gnp = (BR == 0 ? a.in[I_SNG] : (BR == 1 ? a.in[I_GNG] : a.in[I_HNG])) + (l * 4 + h) * 64;
    const float Dh = BR == 0 ? a.in[I_SD][l * 4 + h] : 0.f;
    float* sloc = (float*)(a.ws + (BR == 0 ? WS_SS : (BR == 1 ? WS_SG : WS_SH))) + (size_t)(bh * NCH + c) * 4096;
    MK_OPQ(sloc);

    lds_barrier();
    if (BR == 2) { if (tl < 64) { const int ch = h * 64 + tl; float p[4], mx = -1e30f, sum = 0.f;
#pragma unroll
            for (int i = 0; i < 4; ++i) { p[i] = a.in[I_HLB][i * 256 + ch]; mx = fmaxf(mx, p[i]); }
#pragma unroll
            for (int i = 0; i < 4; ++i) { p[i] = __expf(p[i] - mx); sum += p[i]; }
            float lb = 0.f;
#pragma unroll
            for (int i = 1; i < 4; ++i) if (i <= l) lb += p[i];
            MISC[tl] = lb * __builtin_amdgcn_rcpf(sum); } }
    else { for (int idx = tl; idx < 5 * 192; idx += 256) { const int w = idx / 192, ch = idx - w * 192, part = ch >> 6, d = ch & 63; const int ci = (part == 0 ? uc0 : (part == 1 ? uc1 : uc2)) - (BR == 0 ? UC_XBC : UC_QKV) + d;
            CWL[idx] = w < 4 ? cw[w * NC + ci] : cbias[ci]; } }
    f32x2 S[8], T[8]; float zero_ = 0.f, one_ = 1.f; asm volatile("" : "+v"(zero_), "+v"(one_));
    if (MODE == 1) {
        const float* s_in = sample ? (BR == 0 ? a.in[I_SSSD] : (BR == 1 ? a.in[I_SGDN] : a.in[I_SHG])) + (size_t)((l * 128 + b) * 4 + h) * 4096 : sloc;
        { float tmp[16];
#pragma unroll
          for (int i = 0; i < 16; ++i) tmp[i] = sample ? __builtin_nontemporal_load(s_in + tl + i * 256) : s_in[tl + i * 256];
#pragma unroll
          for (int i = 0; i < 16; ++i) { const int idx = tl + i * 256; SBUF[(idx >> 6) * 65 + (idx & 63)] = tmp[i]; } }
        lds_barrier();
#pragma unroll
        for (int i = 0; i < 8; ++i) { S[i][0] = SBUF[(kq * 8 + i) * 65 + 2 * vp]; S[i][1] = SBUF[(kq * 8 + i) * 65 + 2 * vp + 1]; }
    } else {
#pragma unroll
        for (int i = 0; i < 8; ++i) { S[i][0] = zero_; S[i][1] = zero_;
            T[i][0] = (BR == 1) ? ((kq * 8 + i == 2 * vp) ? one_ : zero_) : one_; T[i][1] = (BR == 1) ? ((kq * 8 + i == 2 * vp + 1) ? one_ : zero_) : one_; }
    }
    float decprod = one_, tprod = one_;
    f32x4 lacc[4] = {{zero_, zero_, zero_, zero_}, {zero_, zero_, zero_, zero_}, {zero_, zero_, zero_, zero_}, {zero_, zero_, zero_, zero_}};

    for (int ts = 0; ts < nsteps; ts += ST) {
        const int n = (nsteps - ts) < ST ? (nsteps - ts) : ST;
        lds_barrier();
        if (BR == 2) {
            u32x4 ld[6];
#pragma unroll
            for (int it = 0; it < 6; ++it) { const int idx = tl + it * 256; const int s = idx >> 5, part = (idx >> 3) & 3, oct = idx & 7; ld[it] = (u32x4){0u, 0u, 0u, 0u};
                if (s < n && !(MODE == 0 && (part & 1))) { const int t = t0 + ts + s; const int row = sample ? ROW_SAMPLE + b * 4 + t : prow(b, t);
                    const int col = (part == 0 ? UC_FD : (part == 1 ? UC_QD : (part == 2 ? UC_ID : UC_ZD))) + h * 64 + oct * 8;
                    ld[it] = *(const u32x4*)(U + (size_t)row * NU + col); } }
#pragma unroll
            for (int it = 0; it < 6; ++it) { const int idx = tl + it * 256; const int s = idx >> 5, part = (idx >> 3) & 3, oct = idx & 7;
                if (s < n && !(MODE == 0 && (part & 1))) { float x[8];
#pragma unroll
                    for (int j = 0; j < 4; ++j) { x[2 * j] = __uint_as_float(ld[it][j] << 16); x[2 * j + 1] = __uint_as_float(ld[it][j] & 0xffff0000u); }
                    if (part == 0) {
#pragma unroll
                        for (int j = 0; j < 8; ++j) { const float lb = MISC[oct * 8 + j]; x[j] = lb + (1.f - lb) * sigm(x[j]); } }
                    else if (part == 1) {
#pragma unroll
                        for (int j = 0; j < 8; ++j) x[j] = silu(x[j]); }
                    if (part == 3) *(MK_LAS u32x4*)(ZB + s * 64 + oct * 8) = ld[it];
                    else { lfloat* dst = ACT + s * 256 + part * 64 + oct * 8; *(lf32x4*)dst = (f32x4){x[0], x[1], x[2], x[3]}; *(lf32x4*)(dst + 4) = (f32x4){x[4], x[5], x[6], x[7]}; } } }
            lds_barrier();
        } else {
            u32x4 ld[6]; f32x4 lf0[6], lf1[6];
#pragma unroll
            for (int it = 0; it < 6; ++it) { const int idx = tl + it * 256; const int j = idx >> 5, part = (idx >> 3) & 3, oct = idx & 7, t = t0 + ts - 3 + j;
                ld[it] = (u32x4){0u, 0u, 0u, 0u}; lf0[it] = (f32x4){0.f, 0.f, 0.f, 0.f}; lf1[it] = lf0[it];
                if (j < n + 3 && !(MODE == 0 && (part == 3 || part == (BR == 0 ? 2 : 0)))) { const int ucb = part == 0 ? uc0 : (part == 1 ? uc1 : (part == 2 ? uc2 : zcol));
                    if (t >= 0) { if (part < 3 || j >= 3) { const int row = sample ? ROW_SAMPLE + b * 4 + t : prow(b, t); ld[it] = *(const u32x4*)(U + (size_t)row * NU + ucb + oct * 8); } }
                    else if (sample && part < 3) { const float* cp = cstate + (3 + t) * NC + ucb - (BR == 0 ? UC_XBC : UC_QKV) + oct * 8; lf0[it] = *(const f32x4*)cp; lf1[it] = *(const f32x4*)(cp + 4); } } }
            if (tl < n) { const int t = t0 + ts + tl; const int row = sample ? ROW_SAMPLE + b * 4 + t : prow(b, t);
                if (BR == 0) { const float dtv = softplus(USM[(size_t)row * 16 + h] + a.in[I_SDTB][l * 4 + h]); const float aa = -dtv * __expf(a.in[I_SALOG][l * 4 + h]); SCAL[tl * 2] = __expf(aa); SCAL[tl * 2 + 1] = dtv; }
                else { const float beta = sigm(USM[(size_t)row * 16 + 4 + h]); const float g = -__expf(a.in[I_GALOG][l * 4 + h]) * softplus(USM[(size_t)row * 16 + 8 + h] + a.in[I_GDTB][l * 4 + h]); SCAL[tl * 2] = __expf(g); SCAL[tl * 2 + 1] = beta; } }
#pragma unroll
            for (int it = 0; it < 6; ++it) { const int idx = tl + it * 256; const int j = idx >> 5, part = (idx >> 3) & 3, oct = idx & 7, t = t0 + ts - 3 + j;
                if (j < n + 3 && (part < 3 || j >= 3) && !(MODE == 0 && (part == 3 || part == (BR == 0 ? 2 : 0)))) { u32x4 rw = ld[it];
                    if (t < 0) { rw.x = pk2(lf0[it][0], lf0[it][1]); rw.y = pk2(lf0[it][2], lf0[it][3]); rw.z = pk2(lf1[it][0], lf1[it][1]); rw.w = pk2(lf1[it][2], lf1[it][3]); }
                    if (part == 3) *(MK_LAS u32x4*)(ZB + (j - 3) * 64 + oct * 8) = rw; else *(MK_LAS u32x4*)(RAW + j * 192 + part * 64 + oct * 8) = rw; } }
            lds_barrier();
            constexpr int NCG = (MODE == 0) ? 32 : 48, CH0 = (MODE == 0 && BR == 1) ? 64 : 0;
            for (int idx = tl; idx < n * NCG; idx += 256) { const int s = idx / NCG, ch = CH0 + (idx - s * NCG) * 4, part = ch >> 6, d = ch & 63;
                f32x4 acc = *(const lf32x4*)(CWL + 4 * 192 + ch);
#pragma unroll
                for (int w = 0; w < 4; ++w) { const u32x2 rv = *(const MK_LAS u32x2*)(RAW + (s + w) * 192 + ch);
                    acc += *(const lf32x4*)(CWL + w * 192 + ch) * (f32x4){__uint_as_float(rv.x << 16), __uint_as_float(rv.x & 0xffff0000u), __uint_as_float(rv.y << 16), __uint_as_float(rv.y & 0xffff0000u)}; }
                acc = (f32x4){silu(acc[0]), silu(acc[1]), silu(acc[2]), silu(acc[3])};
                if (BR == 0) { if (part == 0) { *(lf32x4*)(ACT + s * 256 + 192 + d) = acc; *(lf32x4*)(ACT + s * 256 + 128 + d) = acc * SCAL[s * 2 + 1]; } else if (part == 1) *(lf32x4*)(ACT + s * 256 + d) = acc; else *(lf32x4*)(ACT + s * 256 + 64 + d) = acc; }
                else { if (part == 0) *(lf32x4*)(ACT + s * 256 + 64 + d) = acc; else if (part == 1) *(lf32x4*)(ACT + s * 256 + d) = acc; else *(lf32x4*)(ACT + s * 256 + 128 + d) = acc; } }
            lds_barrier();
            if (BR == 1) {
#pragma unroll
                for (int pass = 0; pass < 3; ++pass) { const int r = pass * 32 + vp;
                    if (r < (MODE == 0 ? n : 2 * n)) { const int s = MODE == 0 ? r : (r >> 1), isq = MODE == 0 ? 0 : (r & 1); lfloat* p = ACT + s * 256 + (isq ? 64 : 0) + kq * 8; const f32x4 x0 = *(lf32x4*)p, x1 = *(lf32x4*)(p + 4);
                        float ss = (x0[0] * x0[0] + x0[1] * x0[1]) + (x0[2] * x0[2] + x0[3] * x0[3]) + (x1[0] * x1[0] + x1[1] * x1[1]) + (x1[2] * x1[2] + x1[3] * x1[3]);
                        ss = red8(ss); const float sc = __builtin_amdgcn_rsqf(ss + L2_EPS) * (isq ? 0.125f : 1.f);
                        *(lf32x4*)p = x0 * sc; *(lf32x4*)(p + 4) = x1 * sc; }
                    else { (void)red8(0.f); } }
                lds_barrier(); }
        }
        if (MODE == 0 && BR != 1) {
            const int lane = tid & 63, kt = (tl >> 6), n4 = (n + 3) & ~3;
            if (BR == 0) { if (tl == 0) { float dv[ST];
#pragma unroll
                    for (int s = 0; s < ST; ++s) dv[s] = s < n ? SCAL[s * 2] : one_;
                    float run = one_;
#pragma unroll
                    for (int s = ST - 1; s >= 0; --s) { if (s < n) SCAL[s * 2 + 1] = run; run *= dv[s]; }
                    SCAL[2 * ST] = run; } }
            else { if (tl < 64) { float fv[ST];
#pragma unroll
                    for (int s = 0; s < ST; ++s) fv[s] = s < n ? ACT[s * 256 + tl] : one_;
                    float run = one_;
#pragma unroll
                    for (int s = ST - 1; s >= 0; --s) { if (s < n) ACT[s * 256 + tl] = (1.f - fv[s]) * run; run *= fv[s]; }
                    CWL[tl] = run; tprod *= run; } }
            for (int idx = tl; idx < (n4 - n) * 64; idx += 256) { const int s = n + (idx >> 6), d = idx & 63; ACT[s * 256 + d] = 0.f; ACT[s * 256 + 128 + d] = 0.f; }
            lds_barrier();
            if (BR == 0) { const float Dt = SCAL[2 * ST]; decprod *= Dt;
#pragma unroll
                for (int vt = 0; vt < 4; ++vt) lacc[vt] = lacc[vt] * Dt; }
            else {
#pragma unroll
                for (int r = 0; r < 4; ++r) { const float dk = CWL[kt * 16 + 4 * (lane >> 4) + r];
#pragma unroll
                    for (int vt = 0; vt < 4; ++vt) lacc[vt][r] *= dk; } }
            for (int s0 = 0; s0 < n4; s0 += 4) { const int sr = s0 + (lane >> 4); const lfloat* rp = ACT + sr * 256 + (lane & 15); float av = rp[kt * 16];
                if (BR == 0) av *= (sr < n ? SCAL[sr * 2 + 1] : 0.f);
#pragma unroll
                for (int vt = 0; vt < 4; ++vt) lacc[vt] = __builtin_amdgcn_mfma_f32_16x16x4f32(av, rp[128 + vt * 16], lacc[vt], 0, 0, 0); }
        } else
#define REC_BODY(a0, a1, b0, b1, vv, sc0, sc1, s) do { \
    const float A[8] = {a0[0], a0[1], a0[2], a0[3], a1[0], a1[1], a1[2], a1[3]}; \
    const float Bq[8] = {b0[0], b0[1], b0[2], b0[3], b1[0], b1[1], b1[2], b1[3]}; \
    if (BR == 0) { \
    if (MODE == 0) { decprod *= sc0; \
    _Pragma("unroll") \
    for (int i = 0; i < 8; ++i) S[i] = S[i] * sc0 + vv * A[i]; \
    } else { f32x2 ya = {0.f, 0.f}; \
    _Pragma("unroll") \
    for (int i = 0; i < 8; ++i) { S[i] = S[i] * sc0 + vv * A[i]; ya += S[i] * Bq[i]; } \
    f32x2 y; y[0] = red8(ya[0]); y[1] = red8(ya[1]); if (kq == 0) *(lf32x2*)(OBUF + s * 64 + 2 * vp) = y; } \
    } else if (BR == 1) { \
    if (MODE == 0) { f32x2 ra = {0.f, 0.f}, rp = {0.f, 0.f}; \
    _Pragma("unroll") \
    for (int i = 0; i < 8; ++i) { S[i] *= sc0; T[i] *= sc0; ra += S[i] * A[i]; rp += T[i] * A[i]; } \
    f32x2 r, rpp; r[0] = red8(ra[0]); r[1] = red8(ra[1]); rpp[0] = red8(rp[0]); rpp[1] = red8(rp[1]); \
    const f32x2 vn = (vv - r) * sc1, vnp = rpp * (-sc1); \
    _Pragma("unroll") \
    for (int i = 0; i < 8; ++i) { S[i] += vn * A[i]; T[i] += vnp * A[i]; } \
    } else { f32x2 ra = {0.f, 0.f}; \
    _Pragma("unroll") \
    for (int i = 0; i < 8; ++i) { S[i] *= sc0; ra += S[i] * A[i]; } \
    f32x2 r; r[0] = red8(ra[0]); r[1] = red8(ra[1]); \
    const f32x2 vn = (vv - r) * sc1; f32x2 oa = {0.f, 0.f}; \
    _Pragma("unroll") \
    for (int i = 0; i < 8; ++i) { S[i] += vn * A[i]; oa += S[i] * Bq[i]; } \
    f32x2 o; o[0] = red8(oa[0]); o[1] = red8(oa[1]); if (kq == 0) *(lf32x2*)(OBUF + s * 64 + 2 * vp) = o; } \
    } else { \
    if (MODE == 0) { \
    _Pragma("unroll") \
    for (int i = 0; i < 8; ++i) { S[i] = S[i] * A[i] + vv * (1.f - A[i]); T[i] *= A[i]; } \
    } else { f32x2 oa = {0.f, 0.f}; \
    _Pragma("unroll") \
    for (int i = 0; i < 8; ++i) { S[i] = S[i] * A[i] + vv * (1.f - A[i]); oa += S[i] * Bq[i]; } \
    f32x2 o; o[0] = red8(oa[0]); o[1] = red8(oa[1]); if (kq == 0) *(lf32x2*)(OBUF + s * 64 + 2 * vp) = o; } \
    } \
    } while (0)
#define REC_FETCH(a0, a1, b0, b1, vv, sc0, sc1, SI) do { const int si_ = (SI); const lfloat* an_ = ACT + si_ * 256 + kq * 8; \
    a0 = *(const lf32x4*)(an_); a1 = *(const lf32x4*)(an_ + 4); if (MODE == 1) { b0 = *(const lf32x4*)(an_ + 64); b1 = *(const lf32x4*)(an_ + 68); } \
    vv = *(const lf32x2*)(ACT + si_ * 256 + 128 + 2 * vp); sc0 = (BR != 2) ? SCAL[si_ * 2] : 0.f; sc1 = (BR == 1) ? SCAL[si_ * 2 + 1] : 0.f; } while (0)
        if (MODE == 0)
        {
            const lfloat* ar = ACT + kq * 8;
            f32x4 a0 = *(const lf32x4*)(ar), a1 = *(const lf32x4*)(ar + 4), b0 = *(const lf32x4*)(ar + 64), b1 = *(const lf32x4*)(ar + 68);
            f32x2 vv = *(const lf32x2*)(ACT + 128 + 2 * vp); float sc0 = (BR != 2) ? SCAL[0] : 0.f, sc1 = (BR == 1) ? SCAL[1] : 0.f;
#pragma unroll 2
            for (int s = 0; s < n; ++s) {
                const int sn = (s + 1 < n) ? s + 1 : s;
                const lfloat* an = ACT + sn * 256 + kq * 8;
                const f32x4 na0 = *(const lf32x4*)(an), na1 = *(const lf32x4*)(an + 4);
                f32x4 nb0 = b0, nb1 = b1;
                if (MODE == 1) { nb0 = *(const lf32x4*)(an + 64); nb1 = *(const lf32x4*)(an + 68); }
                const f32x2 nvv = *(const lf32x2*)(ACT + sn * 256 + 128 + 2 * vp); const float nsc0 = (BR != 2) ? SCAL[sn * 2] : 0.f, nsc1 = (BR == 1) ? SCAL[sn * 2 + 1] : 0.f;
                const float A[8] = {a0[0], a0[1], a0[2], a0[3], a1[0], a1[1], a1[2], a1[3]};
                const float Bq[8] = {b0[0], b0[1], b0[2], b0[3], b1[0], b1[1], b1[2], b1[3]};
                if (BR == 0) {
                    if (MODE == 0) { decprod *= sc0;
#pragma unroll
                        for (int i = 0; i < 8; ++i) S[i] = S[i] * sc0 + vv * A[i];
                    } else { f32x2 ya = {0.f, 0.f};
#pragma unroll
                        for (int i = 0; i < 8; ++i) { S[i] = S[i] * sc0 + vv * A[i]; ya += S[i] * Bq[i]; }
                        f32x2 y; y[0] = red8(ya[0]); y[1] = red8(ya[1]); if (kq == 0) *(lf32x2*)(OBUF + s * 64 + 2 * vp) = y; }
                } else if (BR == 1) {
                    if (MODE == 0) { f32x2 ra = {0.f, 0.f}, rp = {0.f, 0.f};
#pragma unroll
                        for (int i = 0; i < 8; ++i) { S[i] *= sc0; T[i] *= sc0; ra += S[i] * A[i]; rp += T[i] * A[i]; }
                        f32x2 r, rpp; r[0] = red8(ra[0]); r[1] = red8(ra[1]); rpp[0] = red8(rp[0]); rpp[1] = red8(rp[1]);
                        const f32x2 vn = (vv - r) * sc1, vnp = rpp * (-sc1);
#pragma unroll
                        for (int i = 0; i < 8; ++i) { S[i] += vn * A[i]; T[i] += vnp * A[i]; }
                    } else { f32x2 ra = {0.f, 0.f};
#pragma unroll
                        for (int i = 0; i < 8; ++i) { S[i] *= sc0; ra += S[i] * A[i]; }
                        f32x2 r; r[0] = red8(ra[0]); r[1] = red8(ra[1]);
                        const f32x2 vn = (vv - r) * sc1; f32x2 oa = {0.f, 0.f};
#pragma unroll
                        for (int i = 0; i < 8; ++i) { S[i] += vn * A[i]; oa += S[i] * Bq[i]; }
                        f32x2 o; o[0] = red8(oa[0]); o[1] = red8(oa[1]); if (kq == 0) *(lf32x2*)(OBUF + s * 64 + 2 * vp) = o; }
                } else {
                    if (MODE == 0) {
#pragma unroll
                        for (int i = 0; i < 8; ++i) { S[i] = S[i] * A[i] + vv * (1.f - A[i]); T[i] *= A[i]; }
                    } else { f32x2 oa = {0.f, 0.f};
#pragma unroll
                        for (int i = 0; i < 8; ++i) { S[i] = S[i] * A[i] + vv * (1.f - A[i]); oa += S[i] * Bq[i]; }
                        f32x2 o; o[0] = red8(oa[0]); o[1] = red8(oa[1]); if (kq == 0) *(lf32x2*)(OBUF + s * 64 + 2 * vp) = o; }
                }
                a0 = na0; a1 = na1; b0 = nb0; b1 = nb1; vv = nvv; sc0 = nsc0; sc1 = nsc1;
            }
        }
        else
        {
            f32x4 pa0, pa1, pb0, pb1, qa0, qa1, qb0, qb1; pb0 = pb1 = qb0 = qb1 = pa0 = pa1 = qa0 = qa1 = (f32x4){zero_, zero_, zero_, zero_}; f32x2 pvv, qvv; float psc0, psc1, qsc0, qsc1;
            REC_FETCH(pa0, pa1, pb0, pb1, pvv, psc0, psc1, 0);
#pragma nounroll
            for (int s = 0; s < n; s += 2) {
                REC_FETCH(qa0, qa1, qb0, qb1, qvv, qsc0, qsc1, (s + 1 < n) ? s + 1 : s);
                REC_BODY(pa0, pa1, pb0, pb1, pvv, psc0, psc1, s);
                if (s + 1 < n) {
                    REC_FETCH(pa0, pa1, pb0, pb1, pvv, psc0, psc1, (s + 2 < n) ? s + 2 : s + 1);
                    REC_BODY(qa0, qa1, qb0, qb1, qvv, qsc0, qsc1, (s + 1));
                }
            }
        }
#undef REC_BODY
#undef REC_FETCH
        if (MODE == 1) {
            lds_barrier();
#pragma unroll
            for (int pass = 0; pass < 2; ++pass) {
                const int sidx = pass * 32 + vp; float ss = 0.f; float o[8];
                if (sidx < n) { const f32x4 o0 = *(const lf32x4*)(OBUF + sidx * 64 + kq * 8), o1 = *(const lf32x4*)(OBUF + sidx * 64 + kq * 8 + 4);
                    o[0] = o0[0]; o[1] = o0[1]; o[2] = o0[2]; o[3] = o0[3]; o[4] = o1[0]; o[5] = o1[1]; o[6] = o1[2]; o[7] = o1[3];
                    if (BR == 0) {
#pragma unroll
                        for (int i = 0; i < 8; ++i) o[i] += Dh * ACT[sidx * 256 + 192 + kq * 8 + i]; }
#pragma unroll
                    for (int i = 0; i < 8; ++i) ss += o[i] * o[i]; }
                ss = red8(ss);
                if (sidx < n) { const int t = t0 + ts + sidx; const int row = sample ? ROW_SAMPLE + b * 4 + t : prow(b, t);
                    const float r = __builtin_amdgcn_rsqf(ss * (1.f / 64.f) + RMS_EPS);
                    const f32x4 g0 = *(const f32x4*)(gnp + kq * 8), g1 = *(const f32x4*)(gnp + kq * 8 + 4);
                    const u32x4 zw = *(const MK_LAS u32x4*)(ZB + sidx * 64 + kq * 8);
                    const float z[8] = {__uint_as_float(zw.x << 16), __uint_as_float(zw.x & 0xffff0000u), __uint_as_float(zw.y << 16), __uint_as_float(zw.y & 0xffff0000u),
                                        __uint_as_float(zw.z << 16), __uint_as_float(zw.z & 0xffff0000u), __uint_as_float(zw.w << 16), __uint_as_float(zw.w & 0xffff0000u)};
                    u32x4 w; w.x = pk2(o[0] * r * g0[0] * silu(z[0]), o[1] * r * g0[1] * silu(z[1])); w.y = pk2(o[2] * r * g0[2] * silu(z[2]), o[3] * r * g0[3] * silu(z[3]));
                    w.z = pk2(o[4] * r * g1[0] * silu(z[4]), o[5] * r * g1[1] * silu(z[5])); w.w = pk2(o[6] * r * g1[2] * silu(z[6]), o[7] * r * g1[3] * silu(z[7]));
                    *(u32x4*)(MIX + (size_t)row * 1024 + mixcol + kq * 8) = w; }
            }
        }
    }
    if (MODE == 0 && BR != 1) {
        const int lane = tid & 63, kt = (tl >> 6);
#pragma unroll
        for (int vt = 0; vt < 4; ++vt)
#pragma unroll
            for (int r = 0; r < 4; ++r) sloc[(kt * 16 + 4 * (lane >> 4) + r) * 64 + vt * 16 + (lane & 15)] = lacc[vt][r];
        if (BR == 0 && tl == 0) ((float*)(a.ws + WS_DS))[bh * NCH + c] = decprod;
        if (BR == 2 && tl < 64) ((float*)(a.ws + WS_DH))[(bh * NCH + c) * 64 + tl] = tprod;
    } else
    if (MODE == 0 || sample) {
        float* dst = MODE == 0 ? sloc : a.out + (BR == 0 ? O_SSSD : (BR == 1 ? O_SGDN : O_SHG)) + (size_t)((l * 128 + b) * 4 + h) * 4096;
        lds_barrier();
#pragma unroll
        for (int i = 0; i < 8; ++i) { SBUF[(kq * 8 + i) * 65 + 2 * vp] = S[i][0]; SBUF[(kq * 8 + i) * 65 + 2 * vp + 1] = S[i][1]; }
        if (MODE == 0 && BR == 1) {
#pragma unroll
            for (int i = 0; i < 8; ++i) { SBUF2[(kq * 8 + i) * 65 + 2 * vp] = T[i][0]; SBUF2[(kq * 8 + i) * 65 + 2 * vp + 1] = T[i][1]; } }
        lds_barrier();
        for (int idx = tl; idx < 4096; idx += 256) { const float sv = SBUF[(idx >> 6) * 65 + (idx & 63)]; if (MODE == 1) __builtin_nontemporal_store(sv, dst + idx); else dst[idx] = sv; }
        if (MODE == 0 && BR == 1) { float* pd = (float*)(a.ws + WS_PG) + (size_t)(bh * NCH + c) * 4096; for (int idx = tl; idx < 4096; idx += 256) pd[idx] = SBUF2[(idx >> 6) * 65 + (idx & 63)]; }
        if (MODE == 0 && BR == 0 && tl == 0) ((float*)(a.ws + WS_DS))[bh * NCH + c] = decprod;
        if (MODE == 0 && BR == 2 && vp == 0) {
#pragma unroll
            for (int i = 0; i < 8; ++i) ((float*)(a.ws + WS_DH))[(bh * NCH + c) * 64 + kq * 8 + i] = T[i][0]; }
    }
}

constexpr int L5_CRE = 0, L5_CIM = 4352, L5_UB = 8704, L5_HB = 16896;
static_assert(L5_HB + 8 * 16 * 132 * 4 <= 131072, "lds5");
template <int MODE>
__device__ __forceinline__ void s5_task(CArgs& a, unsigned char* ldsg, const int l, const bool sample, const int g, const int c) {
    MK_LAS unsigned char* lds = (MK_LAS unsigned char*)ldsg;
    lfloat* CRE = (lfloat*)(lds + L5_CRE); lfloat* CIM = (lfloat*)(lds + L5_CIM);
    const int tid = otid(), lane = tid & 63, wave = tid >> 6;
    lfloat* UB = (lfloat*)(lds + L5_UB) + wave * 256; MK_LAS bf16_t* HB = (MK_LAS bf16_t*)(lds + L5_HB) + wave * 16 * 136;
    const bf16_t* U = (const bf16_t*)(a.ws + WS_U); bf16_t* Y5 = (bf16_t*)(a.ws + WS_Y5);
    MK_OPQ(U); MK_OPQ(Y5);
    const int b = sample ? c * 8 + wave : wave, nsteps = sample ? TS : CL, t0 = sample ? 0 : c * CL, lg = l * 16 + g;
    const float dt = __expf(a.in[I_LOGDT][lg]); const float lr = a.in[I_LAMR][lg * 64 + lane], li = a.in[I_LAMI][lg * 64 + lane];
    const float mag = __expf(lr * dt); float sn, cs; { float rv = li * dt * 0.15915494309189535f; rv -= rintf(rv); sn = __builtin_amdgcn_sinf(rv); cs = __builtin_amdgcn_cosf(rv); }
    const float lbr = mag * cs, lbi = mag * sn, den = lr * lr + li * li, nr = lbr - 1.f;
    const float rden = __builtin_amdgcn_rcpf(den); const float cr = (nr * lr + lbi * li) * rden, ci = (lbi * lr - nr * li) * rden;
    float bbr[16], bbi[16];
    { const f32x4* pr = (const f32x4*)(a.in[I_BR] + (size_t)(lg * 64 + lane) * 16); const f32x4* pi = (const f32x4*)(a.in[I_BI] + (size_t)(lg * 64 + lane) * 16);
#pragma unroll
        for (int j = 0; j < 4; ++j) { const f32x4 r = pr[j], im = pi[j];
#pragma unroll
            for (int k = 0; k < 4; ++k) { bbr[j * 4 + k] = cr * r[k] - ci * im[k]; bbi[j * 4 + k] = cr * im[k] + ci * r[k]; } } }
    __syncthreads();
    pg8::bf16x8 cfrag[4];
    if (MODE == 1) {
#pragma unroll
        for (int kb = 0; kb < 4; ++kb)
#pragma unroll
            for (int j = 0; j < 8; ++j) { const int k = (kb & 1) * 32 + (lane >> 4) * 8 + j;
                const float cv = kb < 2 ? a.in[I_CR][(size_t)lg * 1024 + (lane & 15) * 64 + k] : -a.in[I_CI][(size_t)lg * 1024 + (lane & 15) * 64 + k];
                cfrag[kb][j] = (short)f2bf(cv); } }
    float* h5 = (float*)(a.ws + WS_H5) + (size_t)((b * 16 + g) * NCH + c) * 128;
    float hr = 0.f, hi = 0.f;
    if (MODE == 1) { if (sample) { hr = a.in[I_SS5R][(size_t)((l * 128 + b) * 16 + g) * 64 + lane]; hi = a.in[I_SS5I][(size_t)((l * 128 + b) * 16 + g) * 64 + lane]; } else { hr = h5[lane]; hi = h5[64 + lane]; } }
    __syncthreads();
    const int tt = lane >> 2, qq = lane & 3;
    float dq = 0.f;
    if (MODE == 1) dq = a.in[I_S5D][lg * 16 + (lane & 15)];
    for (int ts = 0; ts < nsteps; ts += 16) {
        const int n = (nsteps - ts) < 16 ? (nsteps - ts) : 16;
        { f32x4 uv = {0.f, 0.f, 0.f, 0.f};
          if (tt < n) { const int t = t0 + ts + tt; const int row = sample ? ROW_SAMPLE + b * 4 + t : prow(b, t); const u32x2 w = *(const u32x2*)(U + (size_t)row * NU + UC_UB + g * 16 + qq * 4);
              uv[0] = __uint_as_float(w.x << 16); uv[1] = __uint_as_float(w.x & 0xffff0000u); uv[2] = __uint_as_float(w.y << 16); uv[3] = __uint_as_float(w.y & 0xffff0000u); }
          *(lf32x4*)(UB + tt * 16 + qq * 4) = uv; }
        __builtin_amdgcn_wave_barrier(); asm volatile("s_waitcnt lgkmcnt(0)" ::: "memory");
        for (int s = 0; s < n; ++s) {
            float bur = 0.f, bui = 0.f;
#pragma unroll
            for (int j = 0; j < 4; ++j) { const f32x4 uu = *(const lf32x4*)(UB + s * 16 + j * 4);
#pragma unroll
                for (int k = 0; k < 4; ++k) { bur += bbr[j * 4 + k] * uu[k]; bui += bbi[j * 4 + k] * uu[k]; } }
            const float nhr = lbr * hr - lbi * hi + bur, nhi = lbr * hi + lbi * hr + bui; hr = nhr; hi = nhi;
            if (MODE == 1) { HB[s * 136 + lane] = f2bf(hr); HB[s * 136 + 64 + lane] = f2bf(hi); }
        }
        if (MODE == 1) {
            __builtin_amdgcn_wave_barrier(); asm volatile("s_waitcnt lgkmcnt(0)" ::: "memory");
            {
                f32x4 d = {0.f, 0.f, 0.f, 0.f};
#pragma unroll
                for (int kb = 0; kb < 4; ++kb) { const pg8::bf16x8 af = *(const MK_LAS pg8::bf16x8*)(HB + (lane & 15) * 136 + kb * 32 + (lane >> 4) * 8);
                    d = __builtin_amdgcn_mfma_f32_16x16x32_bf16(af, cfrag[kb], d, 0, 0, 0); }
                const int q = lane & 15;
#pragma unroll
                for (int r = 0; r < 4; ++r) { const int st = 4 * (lane >> 4) + r;
                    if (st < n) { const int t = t0 + ts + st; const int row = sample ? ROW_SAMPLE + b * 4 + t : prow(b, t);
                        Y5[(size_t)row * 256 + g * 16 + q] = f2bf(gelu_tanh(d[r] + dq * UB[st * 16 + q])); } }
            }
            __builtin_amdgcn_wave_barrier(); asm volatile("s_waitcnt lgkmcnt(0)" ::: "memory");
        }
    }
    if (MODE == 0) { h5[lane] = hr; h5[64 + lane] = hi; }
    else if (sample) { a.out[O_SS5R + (size_t)((l * 128 + b) * 16 + g) * 64 + lane] = hr; a.out[O_SS5I + (size_t)((l * 128 + b) * 16 + g) * 64 + lane] = hi; }
}

__device__ __forceinline__ void conv_copy_task(CArgs& a, int l, int part, int nparts) {
    const bf16_t* U = (const bf16_t*)(a.ws + WS_U); MK_OPQ(U);
    const int tid = otid();
    for (int unit = part; unit < 136 * 3; unit += nparts) {
        const int sb = unit / 3, j = unit - sb * 3; const bool smp = sb >= 8; const int b = smp ? sb - 8 : sb;
        const int row = smp ? ROW_SAMPLE + b * 4 + 1 + j : prow(b, TP - 3 + j);
        const bf16_t* ur = U + (size_t)row * NU;
        float* o1 = a.out + (smp ? O_SSSDC + (size_t)(l * 128 + b) * SZ_SC : O_PSSDC + (size_t)(l * 8 + b) * SZ_SC) + j * 512;
        float* o2 = a.out + (smp ? O_SGDNC + (size_t)(l * 128 + b) * SZ_GC : O_PGDNC + (size_t)(l * 8 + b) * SZ_GC) + j * 768;
        MK_OPQ(ur); MK_OPQ(o1); MK_OPQ(o2);
        for (int ch = tid; ch < 1280; ch += 512) { if (ch < 512) o1[ch] = bf2f(ur[UC_XBC + ch]); else o2[ch - 512] = bf2f(ur[UC_QKV + ch - 512]); }
    }
}

__device__ __forceinline__ void pass2_gdn(CArgs& a, unsigned char* ldsg, int l, int bh, int vb) {
    MK_LAS unsigned char* lds = (MK_LAS unsigned char*)ldsg;
    lfloat* PL = (lfloat*)lds; lfloat* SL = (lfloat*)(lds + 64 * 68 * 4);
    const int tid = otid(), k = tid >> 3, vv = tid & 7;
    float* sg = (float*)(a.ws + WS_SG) + (size_t)bh * NCH * 4096; const float* pg = (const float*)(a.ws + WS_PG) + (size_t)bh * NCH * 4096;
    MK_OPQ(sg); MK_OPQ(pg);
    lds_barrier();
    float cur = 0.f; asm volatile("" : "+v"(cur));
    SL[k * 8 + vv] = cur;
    f32x4 p0 = *(const f32x4*)(pg + tid * 8), p1 = *(const f32x4*)(pg + tid * 8 + 4);
    float lval = sg[k * 64 + vb * 8 + vv];
    for (int c = 0; c < NCH; ++c) {
        { const int r = tid >> 3, cc = (tid & 7) * 8; *(lf32x4*)(PL + r * 68 + cc) = p0; *(lf32x4*)(PL + r * 68 + cc + 4) = p1; }
        float* slot = sg + (size_t)c * 4096 + k * 64 + vb * 8 + vv;
        float acc = lval;
        if (c + 1 < NCH) { const float* pc = pg + (size_t)(c + 1) * 4096; p0 = *(const f32x4*)(pc + tid * 8); p1 = *(const f32x4*)(pc + tid * 8 + 4); lval = slot[4096]; }
        lds_barrier();
#pragma unroll 4
        for (int j4 = 0; j4 < 16; ++j4) { const f32x4 p = *(const lf32x4*)(PL + k * 68 + j4 * 4);
#pragma unroll
            for (int q = 0; q < 4; ++q) acc += p[q] * SL[(j4 * 4 + q) * 8 + vv]; }
        *slot = cur;
        lds_barrier();
        cur = acc; SL[k * 8 + vv] = acc;
    }
    const int b = bh >> 2, h = bh & 3;
    a.out[O_PGDN + (size_t)((l * 8 + b) * 4 + h) * 4096 + k * 64 + vb * 8 + vv] = cur;
}
__device__ __forceinline__ void pass2_diag(CArgs& a, int l, int br  , int bh, int quarter) {
    float* ss = (float*)(a.ws + (br == 0 ? WS_SS : WS_SH)) + (size_t)bh * NCH * 4096;
    const float* ds = (const float*)(a.ws + WS_DS) + bh * NCH; const float* dh = (const float*)(a.ws + WS_DH) + (size_t)bh * NCH * 64;
    MK_OPQ(ss); MK_OPQ(ds); MK_OPQ(dh);
    const int e = quarter * 1024 + otid() * 2, k = e >> 6;
    f32x2 lv[NCH]; float dc[NCH];
#pragma unroll
    for (int c = 0; c < NCH; ++c) { lv[c] = *(const f32x2*)(ss + (size_t)c * 4096 + e); dc[c] = br == 0 ? ds[c] : dh[c * 64 + k]; }
    float c0 = 0.f, c1 = 0.f; asm volatile("" : "+v"(c0), "+v"(c1));
#pragma unroll
    for (int c = 0; c < NCH; ++c) { *(f32x2*)(ss + (size_t)c * 4096 + e) = (f32x2){c0, c1}; c0 = dc[c] * c0 + lv[c][0]; c1 = dc[c] * c1 + lv[c][1]; }
    const int b = bh >> 2, h = bh & 3; float* o = a.out + (br == 0 ? O_PSSD : O_PHG) + (size_t)((l * 8 + b) * 4 + h) * 4096 + e;
    o[0] = c0; o[1] = c1;
}
__device__ __forceinline__ void pass2_s5(CArgs& a, int l, int part) {
    const int e = part * 512 + otid(), bg = e >> 6, n = e & 63, b = bg >> 4, g = bg & 15, lg = l * 16 + g;
    const float dt = __expf(a.in[I_LOGDT][lg]); const float lr = a.in[I_LAMR][lg * 64 + n], li = a.in[I_LAMI][lg * 64 + n];
    const float mag = __expf(lr * dt); float sn, cs; { float rv = li * dt * 0.15915494309189535f; rv -= rintf(rv); sn = __builtin_amdgcn_sinf(rv); cs = __builtin_amdgcn_cosf(rv); }
    const float lbr = mag * cs, lbi = mag * sn;
    float pr = lbr, pi = lbi;
    static_assert(CL == 129, "power");
#pragma unroll
    for (int i = 0; i < 7; ++i) { const float t = pr * pr - pi * pi; pi = 2.f * pr * pi; pr = t; }
    { const float t = pr * lbr - pi * lbi; pi = pr * lbi + pi * lbr; pr = t; }
    float* h5 = (float*)(a.ws + WS_H5) + (size_t)bg * NCH * 128;
    float hr = 0.f, hi = 0.f; asm volatile("" : "+v"(hr), "+v"(hi));
    float l0v[NCH], l1v[NCH];
#pragma unroll
    for (int c = 0; c < NCH; ++c) { l0v[c] = h5[c * 128 + n]; l1v[c] = h5[c * 128 + 64 + n]; }
#pragma unroll
    for (int c = 0; c < NCH; ++c) { float* s = h5 + c * 128; s[n] = hr; s[64 + n] = hi;
        const float t = pr * hr - pi * hi + l0v[c]; hi = pr * hi + pi * hr + l1v[c]; hr = t; }
    a.out[O_PS5R + (size_t)((l * 8 + b) * 16 + g) * 64 + n] = hr; a.out[O_PS5I + (size_t)((l * 8 + b) * 16 + g) * 64 + n] = hi;
}

#define XB_TMO      128
#define XB_XCNT(j)  (256  + 64 * (j))
#define XB_XSUB(j)  (1280 + 64 * (j))
#define XB_XGEN(j)  (2304 + 64 * (j))
#define XB_TOP      3328
#define XB_TOPGEN   3392
#define XCD_BAR_WORDS 3456
#define XB_SPIN_CAP (1u << 18)

__device__ __forceinline__ unsigned xb_ld(unsigned* p)              { return __hip_atomic_load(p, __ATOMIC_RELAXED, __HIP_MEMORY_SCOPE_AGENT); }
__device__ __forceinline__ unsigned xb_add(unsigned* p, unsigned v) { return __hip_atomic_fetch_add(p, v, __ATOMIC_RELAXED, __HIP_MEMORY_SCOPE_AGENT); }
__device__ __forceinline__ unsigned xb_xcc_id() { return (unsigned)__builtin_amdgcn_s_getreg((3 << 11) | 20) & 0xFu; }
#define XB_SPIN(cond, bar) do { unsigned _sp = 0; while (cond) { __builtin_amdgcn_s_sleep(1); \
    if ((++_sp & 255u) == 0u) { if (xb_ld(&(bar)[XB_TMO])) break; if (_sp > XB_SPIN_CAP) { atomicAdd(&(bar)[XB_TMO], 1u); break; } } } } while (0)

struct XcdBarrier {
    unsigned* bar; unsigned x;
    volatile MK_LAS unsigned* st;
};

__device__ __forceinline__ XcdBarrier xcd_barrier_post(unsigned* bar, volatile MK_LAS unsigned* st) {
    XcdBarrier b; b.bar = bar; b.x = xb_xcc_id(); b.st = st;
    if (threadIdx.x == 0) (void)xb_add(&bar[XB_XCNT(b.x)], 1u);
    return b;
}
__device__ __forceinline__ void xcd_barrier_complete(unsigned* bar, unsigned x, unsigned& nloc, unsigned& nx) {
    const unsigned G = gridDim.x * gridDim.y * gridDim.z;
    unsigned sum, cnt, mine, sp = 0u;
    for (;;) {
        sum = 0u; cnt = 0u; mine = 0u;
#pragma unroll
        for (unsigned j = 0; j < 16; ++j) { const unsigned c = xb_ld(&bar[XB_XCNT(j)]); sum += c; cnt += (c > 0u) ? 1u : 0u; mine = (j == x) ? c : mine; }
        if (sum == G) break;
        __builtin_amdgcn_s_sleep(1);
        if ((++sp & 255u) == 0u) { if (xb_ld(&bar[XB_TMO])) break; if (sp > XB_SPIN_CAP) { atomicAdd(&bar[XB_TMO], 1u); break; } }
    }
    nloc = mine > 0u ? mine : 1u; nx = cnt > 0u ? cnt : 1u;
}

__device__ __forceinline__ void xcd_barrier(const XcdBarrier& b) {
    asm volatile("s_waitcnt vmcnt(0)" ::: "memory");
    __syncthreads();
    if (threadIdx.x == 0) {
        unsigned* bar = b.bar;
        __builtin_amdgcn_s_waitcnt(0);
        unsigned nloc = b.st[0], nx = b.st[1];
        if (nloc == 0u) { xcd_barrier_complete(bar, b.x, nloc, nx); b.st[0] = nloc; b.st[1] = nx; }
        const unsigned old = xb_add(&bar[XB_XSUB(b.x)], 1u);
        const unsigned gen = old / nloc;
        if (old + 1u == (gen + 1u) * nloc) {
            __builtin_amdgcn_fence(__ATOMIC_RELEASE, "agent");
            asm volatile("s_waitcnt vmcnt(0)" ::: "memory");
            const unsigned og = xb_add(&bar[XB_TOP], 1u);
            const unsigned tg = og / nx;
            if (og + 1u == (tg + 1u) * nx) xb_add(&bar[XB_TOPGEN], 1u);
            else XB_SPIN(xb_ld(&bar[XB_TOPGEN]) == tg, bar);
            __builtin_amdgcn_fence(__ATOMIC_ACQUIRE, "agent");
            xb_add(&bar[XB_XGEN(b.x)], 1u);
            asm volatile("s_waitcnt vmcnt(0)" ::: "memory");
        } else {
            XB_SPIN(xb_ld(&bar[XB_XGEN(b.x)]) == gen, bar);
            __builtin_amdgcn_fence(__ATOMIC_ACQUIRE, "agent");
            asm volatile("s_waitcnt vmcnt(0)" ::: "memory");
        }
    }
    __syncthreads();
}

__device__ __forceinline__ void phase_mixer(CArgs& a, unsigned char* lds, int l, int which  ) {
    const int ntasks = which == 1 ? 2304 : 1024;
    for (int task = obid(); task < ntasks; task += gridDim.x) {
        int kind, p0, p1; bool sample = false;
        if (which == 1) {
            if (task < 768) { kind = task >> 8; p0 = (task & 255) >> 4; p1 = task & 15; }
            else if (task < 1024) { kind = 3; p0 = (task - 768) >> 4; p1 = task & 15; }
            else if (task < 1792) { const int r = task - 1024; kind = 4 + (r >> 8); p0 = r & 255; p1 = 0; sample = true; }
            else if (task < 2048) { const int r = task - 1792; kind = 7; p0 = r >> 4; p1 = r & 15; sample = true; }
            else { kind = 8; p0 = task - 2048; p1 = 0; }
        } else {
            if (task < 768) { kind = 4 + (task >> 8); p0 = (task & 255) >> 4; p1 = task & 15; }
            else { kind = 7; p0 = (task - 768) >> 4; p1 = task & 15; }
        }
        switch (kind) {
            case 0: rec_task<1, 0>(a, lds, l, false, p0 >> 1, p0 & 1, p1); break;
            case 1: rec_task<0, 0>(a, lds, l, false, p0 >> 1, p0 & 1, p1); break;
            case 2: rec_task<2, 0>(a, lds, l, false, p0 >> 1, p0 & 1, p1); break;
            case 3: s5_task<0>(a, lds, l, false, p0, p1); break;
            case 4: rec_task<1, 1>(a, lds, l, sample, p0 >> 1, p0 & 1, p1); break;
            case 5: rec_task<0, 1>(a, lds, l, sample, p0 >> 1, p0 & 1, p1); break;
            case 6: rec_task<2, 1>(a, lds, l, sample, p0 >> 1, p0 & 1, p1); break;
            case 7: s5_task<1>(a, lds, l, sample, p0, p1); break;
            default: conv_copy_task(a, l, p0, 256); break;
        }
    }
}
__device__ __forceinline__ void phase_pass2(CArgs& a, unsigned char* lds, int l) {
    for (int task = obid(); task < 528; task += gridDim.x) {
        if (task < 256) pass2_gdn(a, lds, l, task >> 3, task & 7);
        else if (task < 384) pass2_diag(a, l, 0, (task - 256) >> 2, task & 3);
        else if (task < 512) pass2_diag(a, l, 2, (task - 384) >> 2, task & 3);
        else pass2_s5(a, l, task - 512);
    }
}

template <class Epi>
__device__ __forceinline__ void run_gemm(unsigned char* lds, const bf16_t* A, const bf16_t* Bt, int M, int N, int K, const Epi& E) {
    pg8::Gemm g; g.A = A; g.Bt = Bt; g.M = M; g.N = N; g.K = K;
    pg8::StaticOrder S; S.init(M, N, gridDim.x, obid());
    pg8::gemm_phase<Epi, pg8::StaticOrder, false>((PG8_LAS unsigned char*)lds, g, S, E, nullptr);
}

constexpr int N_PHASES = 1 + 7 * DEPTH;
#ifndef MK_ONE_LAUNCH
#define MK_ONE_LAUNCH 1
#endif

__global__ void __launch_bounds__(512, 2) hybrid_fwd(Args a_in) {
    extern __shared__ __attribute__((aligned(16))) unsigned char lds_[];
    const int ph_lo = a_in.ph_lo, ph_hi = a_in.ph_hi;
#if MK_ONE_LAUNCH
    { volatile MK_LAS unsigned* st = (volatile MK_LAS unsigned*)((MK_LAS unsigned char*)lds_ + L_BARST);
      if (threadIdx.x == 0) { st[0] = 0u; st[1] = 0u; }
      __syncthreads();
      (void)xcd_barrier_post((unsigned*)(a_in.ws + WS_CTL), st); }
#endif
    for (int ph = ph_lo; ph < ph_hi; ++ph) {
        if (ph > ph_lo) {
#if MK_ONE_LAUNCH
            if (ph == ph_lo + 1) cg::this_grid().sync();
            else { XcdBarrier xb_; xb_.bar = (unsigned*)(a_in.ws + WS_CTL); xb_.x = xb_xcc_id(); xb_.st = (volatile MK_LAS unsigned*)((MK_LAS unsigned char*)lds_ + L_BARST); xcd_barrier(xb_); }
#endif
        }
        CArgs* ap = (CArgs*)__builtin_amdgcn_kernarg_segment_ptr();
        asm volatile("" : "+s"(ap));
        CArgs& a = *ap;
        unsigned char* lds = lds_;
        if (ph == 0) { phase_prologue(a, lds); continue; }
        const int l = (ph - 1) / 7, sub = (ph - 1) % 7;
#ifdef MK_DOUBLE
        for (int rep = 0; rep < (sub == MK_DOUBLE ? 2 : 1); ++rep)
#endif
        switch (sub) {
            case 0: { EpiU E; E.U = (bf16_t*)(a.ws + WS_U); E.USM = (float*)(a.ws + WS_USM);
                      run_gemm(lds, (const bf16_t*)(a.ws + WS_XB), (const bf16_t*)(a.ws + WS_WTIN) + (size_t)l * NU_PAD * 1024, MP, NU_PAD, 1024, E); } break;
#ifndef MK_NOMIX
            case 1: case 3: phase_mixer(a, lds, l, sub); break;
            case 2: phase_pass2(a, lds, l); break;
#endif
            case 4: { EpiGlu E; E.Y5 = (const bf16_t*)(a.ws + WS_Y5); E.U = (const bf16_t*)(a.ws + WS_U); E.bias = a.in[I_GLUB] + l * 256; E.MIX = (bf16_t*)(a.ws + WS_XB);
                      run_gemm(lds, (const bf16_t*)(a.ws + WS_Y5), (const bf16_t*)(a.ws + WS_WTGLU) + (size_t)l * 256 * 256, MP, 256, 256, E); } break;
            case 5: { EpiOut E; E.out = a.out; E.xmeta = (float*)(a.ws + WS_XMETA);
                      run_gemm(lds, (const bf16_t*)(a.ws + WS_XB), (const bf16_t*)(a.ws + WS_WTOUT) + (size_t)l * 1024 * 1024, MP, 1024, 1024, E); } break;
            default: phase_ln(a, l); break;
        }
    }
}
}

extern "C" void kernel_launch(void* const* d_in, const int* in_sizes, int n_in, void* d_out, int out_size, void* d_ws, size_t ws_size, hipStream_t stream) {
    using namespace mk;
    static int grid = 0;
    if (!grid) {
        int dev = 0, cus = 0, per_cu = 0;
        hipGetDevice(&dev); hipDeviceGetAttribute(&cus, hipDeviceAttributeMultiprocessorCount, dev);
        hipFuncSetAttribute((const void*)hybrid_fwd, hipFuncAttributeMaxDynamicSharedMemorySize, LDS_BYTES);
        hipOccupancyMaxActiveBlocksPerMultiprocessor(&per_cu, (const void*)hybrid_fwd, 512, LDS_BYTES);
        if (per_cu < 1) { fprintf(stderr, "kernel_launch: occupancy query says %d blocks/CU\n", per_cu); per_cu = 1; }
        grid = cus;
        if (n_in != N_IN || (size_t)out_size != O_END || ws_size < WS_CTL + CTL_BYTES) fprintf(stderr, "kernel_launch: unexpected shapes n_in %d out %d ws %zu\n", n_in, out_size, ws_size);
    }
    Args a{};
    for (int i = 0; i < N_IN; ++i) a.in[i] = (const float*)d_in[i];
    a.out = (float*)d_out; a.ws = (unsigned char*)d_ws;
#if MK_ONE_LAUNCH
    (void)hipMemsetAsync((char*)d_ws + WS_CTL, 0, CTL_BYTES, stream);
    a.ph_lo = 0; a.ph_hi = N_PHASES;
    void* args[] = {&a};
    hipError_t e = hipLaunchCooperativeKernel((const void*)hybrid_fwd, dim3(grid), dim3(512), args, LDS_BYTES, stream);
    if (e != hipSuccess) fprintf(stderr, "cooperative launch failed: %s (grid %d)\n", hipGetErrorString(e), grid);
#else
    for (int ph = 0; ph < N_PHASES; ++ph) { a.ph_lo = ph; a.ph_hi = ph + 1; hipLaunchKernelGGL(hybrid_fwd, dim3(grid), dim3(512), LDS_BYTES, stream, a); }
#endif
}
```
